# Optimizing an MI355X kernel written in HIP

```python
import math
import jax, jax.numpy as jnp
from jax import lax
import numpy as np


D_MODEL = 2048
BATCH = 4
SEQ = 4096
DEPTH = 4

GRID_W = 64
CTX_LEN = 256
N_MIXERS = 2
N_LAYERS_A = (DEPTH + N_MIXERS - 1) // N_MIXERS
N_LAYERS_B = DEPTH // N_MIXERS

MLSTM_HEADS = 8
MLSTM_DK = D_MODEL // (2 * MLSTM_HEADS)
MLSTM_DV = D_MODEL // MLSTM_HEADS
MLSTM_CHUNK = 64
GATE_CAP = 15.0
MLSTM_SPLITS = (MLSTM_HEADS * MLSTM_DK, 2 * MLSTM_HEADS * MLSTM_DK, 2 * MLSTM_HEADS * MLSTM_DK + MLSTM_HEADS * MLSTM_DV, 2 * MLSTM_HEADS * MLSTM_DK + 2 * MLSTM_HEADS * MLSTM_DV)
MLSTM_IN = MLSTM_SPLITS[-1] + 4 * MLSTM_HEADS

DIFF_HEADS = 8
DIFF_DH = D_MODEL // (2 * DIFF_HEADS)
Q_BLOCK = 128
ROPE_BASE = 10000.0
LAMBDA_STD = 0.1

FFN_HIDDEN = -(-(8 * D_MODEL) // (3 * 256)) * 256
EPS = 1e-6

kernel_name = 'hybrid_mlstm_diffattn_block'


def rms_norm(x, g):
    xf = x.astype(jnp.float32)
    y = xf * lax.rsqrt(jnp.mean(xf * xf, axis=-1, keepdims=True) + EPS)
    return (y * g.astype(jnp.float32)).astype(x.dtype)


def modulate(h, shift, scale):
    return h * (1.0 + scale) + shift


def softcap(x, cap):
    return cap * jnp.tanh(x / cap)


def rope_2d(x, cos, sin):
    Bn, S, Hn, dh = x.shape
    xr = x.astype(jnp.float32).reshape(Bn, S, Hn, 2, 2, dh // 4)
    x1 = xr[..., 0, :]
    x2 = xr[..., 1, :]
    c = cos[None, :, None]
    s = sin[None, :, None]
    out = jnp.stack([x1 * c - x2 * s, x2 * c + x1 * s], axis=-2)
    return out.reshape(Bn, S, Hn, dh).astype(x.dtype)


def swiglu(h, w_gu, w_down):
    g, u = jnp.split(h @ w_gu, 2, axis=-1)
    return (jax.nn.silu(g) * u) @ w_down


def mlstm_scan(q, k, v, ig, lf, state):
    Bn, Hn, S, _ = q.shape
    dv = v.shape[-1]
    L = MLSTM_CHUNK
    nc = S // L

    def chunks(a):
        return jnp.moveaxis(a.reshape(Bn, Hn, nc, L, *a.shape[3:]), 2, 0)

    xs = (chunks(q), chunks(k), chunks(v), chunks(ig), chunks(lf))
    mask = jnp.tril(jnp.ones((L, L), dtype=bool))

    def step(carry, inp):
        C, n, m = carry
        qc, kc, vc, ic, fc = inp
        b = jnp.cumsum(fc, axis=-1)
        dmat = b[..., :, None] - b[..., None, :] + ic[..., None, :]
        dmat = jnp.where(mask, dmat, -jnp.inf)
        inter = b + m[..., None]
        m_t = jnp.maximum(inter, jnp.max(dmat, axis=-1))
        w_intra = jnp.exp(dmat - m_t[..., None])
        w_inter = jnp.exp(inter - m_t)
        s = jnp.einsum('bhtd,bhsd->bhts', qc, kc) * w_intra
        num = w_inter[..., None] * jnp.einsum('bhtd,bhde->bhte', qc, C) + jnp.einsum('bhts,bhse->bhte', s, vc)
        den = w_inter * jnp.einsum('bhtd,bhd->bht', qc, n) + jnp.sum(s, axis=-1)
        h = num / jnp.maximum(jnp.abs(den), jnp.exp(-m_t))[..., None]
        bL = b[..., -1]
        a = bL[..., None] - b + ic
        m_new = jnp.maximum(bL + m, jnp.max(a, axis=-1))
        wk = jnp.exp(a - m_new[..., None])
        dec = jnp.exp(bL + m - m_new)
        kw = kc * wk[..., None]
        C_new = dec[..., None, None] * C + jnp.einsum('bhsd,bhse->bhde', kw, vc)
        n_new = dec[..., None] * n + jnp.sum(kw, axis=2)
        return (C_new, n_new, m_new), h

    state, h = lax.scan(step, state, xs)
    h = jnp.moveaxis(h, 0, 2).reshape(Bn, Hn, S, dv)
    return state, h


def mlstm_mixer(hx, hc, w_in, gate_b, head_g, w_out, update_ctx):
    H, DK, DV = MLSTM_HEADS, MLSTM_DK, MLSTM_DV

    def project(h):
        Bn, S, _ = h.shape
        q, k, v, o, g = jnp.split(h @ w_in, MLSTM_SPLITS, axis=-1)

        def heads(a, d):
            return a.reshape(Bn, S, H, d).transpose(0, 2, 1, 3).astype(jnp.float32)

        q = heads(q, DK) * (DK ** -0.5)
        k = heads(k, DK)
        v = heads(v, DV)
        g = softcap(g.astype(jnp.float32) + gate_b.astype(jnp.float32), GATE_CAP)
        g = g.reshape(Bn, S, 4, H).transpose(2, 0, 3, 1)
        gates = (g[0], jax.nn.log_sigmoid(g[1]), g[2], jax.nn.log_sigmoid(g[3]))
        return q, k, v, o, gates

    qx, kx, vx, ox_gate, gx = project(hx)
    qc, kc, vc, oc_gate, gc = project(hc)
    Bn = hx.shape[0]
    state0 = (jnp.zeros((Bn, H, DK, DV), jnp.float32), jnp.zeros((Bn, H, DK), jnp.float32), jnp.zeros((Bn, H), jnp.float32))

    def flip(a):
        return jnp.flip(a, axis=2)

    st_f, hc_f = mlstm_scan(qc, kc, vc, gc[0], gc[1], state0)
    _, hx_f = mlstm_scan(qx, kx, vx, gx[0], gx[1], st_f)
    st_b, hc_b = mlstm_scan(flip(qc), flip(kc), flip(vc), flip(gc[2]), flip(gc[3]), state0)
    _, hx_b = mlstm_scan(flip(qx), flip(kx), flip(vx), flip(gx[2]), flip(gx[3]), st_b)

    def finish(hf, hb, o):
        Bs, _, S, _ = hf.shape
        h = (hf + hb).transpose(0, 2, 1, 3).astype(o.dtype)
        h = rms_norm(h, head_g.reshape(H, DV)).reshape(Bs, S, H * DV)
        return (h * jax.nn.sigmoid(o)) @ w_out

    ox = finish(hx_f, flip(hx_b), ox_gate)
    oc = finish(hc_f, flip(hc_b), oc_gate) if update_ctx else None
    return ox, oc


def diff_attn_mixer(hx, hc, w_in, w_out, q_g, k_g, lq1, lk1, lq2, lk2, subln_g, lam_init, cos, sin, update_ctx):
    H, DH = DIFF_HEADS, DIFF_DH
    scale = DH ** -0.5

    def project(h, rope):
        Bn, S, _ = h.shape
        q, k, v = jnp.split(h @ w_in, 3, axis=-1)
        q = rms_norm(q.reshape(Bn, S, 2 * H, DH), q_g)
        k = rms_norm(k.reshape(Bn, S, 2 * H, DH), k_g)
        if rope:
            q = rope_2d(q, cos, sin)
            k = rope_2d(k, cos, sin)
        v = v.reshape(Bn, S, H, 2 * DH)
        return q.transpose(0, 2, 1, 3), k.transpose(0, 2, 1, 3), v.transpose(0, 2, 1, 3)

    qx, kx, vx = project(hx, True)
    qc, kc, vc = project(hc, False)
    lam = (jnp.exp(jnp.sum(lq1.astype(jnp.float32) * lk1.astype(jnp.float32)))
           - jnp.exp(jnp.sum(lq2.astype(jnp.float32) * lk2.astype(jnp.float32))) + lam_init)

    def attend(q, k, v):
        Bn, _, Q, _ = q.shape
        s = jnp.einsum('bhqd,bhkd->bhqk', q, k).astype(jnp.float32) * scale
        p = jax.nn.softmax(s, axis=-1).reshape(Bn, H, 2, Q, k.shape[2])
        a = p[:, :, 0] - lam * p[:, :, 1]
        return jnp.einsum('bhqk,bhke->bhqe', a.astype(v.dtype), v)

    def finish(o):
        Bn, S = o.shape[0], o.shape[1]
        o = rms_norm(o, subln_g) * (1.0 - lam_init)
        return o.reshape(Bn, S, H * 2 * DH) @ w_out

    k_all = jnp.concatenate([kx, kc], axis=2)
    v_all = jnp.concatenate([vx, vc], axis=2)
    Bn, _, S, _ = qx.shape
    nqb = S // Q_BLOCK
    qb = qx.reshape(Bn, 2 * H, nqb, Q_BLOCK, DH).transpose(2, 0, 1, 3, 4)
    ob = lax.map(lambda q: attend(q, k_all, v_all), qb)
    ox = ob.transpose(1, 0, 3, 2, 4).reshape(Bn, S, H, 2 * DH)
    ox = finish(ox)
    oc = finish(attend(qc, kc, vc).transpose(0, 2, 1, 3)) if update_ctx else None
    return ox, oc


def setup_inputs(seed: int = 0) -> dict:
    key = jax.random.key(seed)
    ks = jax.random.split(key, 24)
    f32 = jnp.float32

    def nrm(k, shape, s):
        return jax.random.normal(k, shape, f32) * s

    H = MLSTM_HEADS
    gate_base = jnp.concatenate([jnp.zeros((H,), f32), jnp.linspace(3.0, 6.0, H, dtype=f32),
                                 jnp.zeros((H,), f32), jnp.linspace(3.0, 6.0, H, dtype=f32)])
    return {
        'x': nrm(ks[0], (BATCH, SEQ, D_MODEL), 1.0),
        'c': nrm(ks[1], (BATCH, D_MODEL), 1.0),
        'ctx': nrm(ks[2], (BATCH, CTX_LEN, D_MODEL), 1.0),
        'c_ctx': nrm(ks[3], (D_MODEL,), 1.0),
        'ada_w': nrm(ks[4], (DEPTH, D_MODEL, 6 * D_MODEL), 0.5 * D_MODEL ** -0.5),
        'ada_b': nrm(ks[5], (DEPTH, 6 * D_MODEL), 0.02),
        'norm_g': 1.0 + nrm(ks[6], (DEPTH, 2, D_MODEL), 0.02),
        'mlstm_w_in': nrm(ks[7], (N_LAYERS_A, D_MODEL, MLSTM_IN), D_MODEL ** -0.5),
        'mlstm_gate_b': gate_base + nrm(ks[8], (N_LAYERS_A, 4 * H), 0.1),
        'mlstm_head_g': 1.0 + nrm(ks[9], (N_LAYERS_A, H * MLSTM_DV), 0.02),
        'mlstm_w_out': nrm(ks[10], (N_LAYERS_A, H * MLSTM_DV, D_MODEL), (H * MLSTM_DV) ** -0.5),
        'diff_w_in': nrm(ks[11], (N_LAYERS_B, D_MODEL, 3 * D_MODEL), D_MODEL ** -0.5),
        'diff_w_out': nrm(ks[12], (N_LAYERS_B, D_MODEL, D_MODEL), D_MODEL ** -0.5),
        'diff_q_g': 1.0 + nrm(ks[13], (N_LAYERS_B, DIFF_DH), 0.02),
        'diff_k_g': 1.0 + nrm(ks[14], (N_LAYERS_B, DIFF_DH), 0.02),
        'diff_lq1': nrm(ks[15], (N_LAYERS_B, DIFF_DH), LAMBDA_STD),
        'diff_lk1': nrm(ks[16], (N_LAYERS_B, DIFF_DH), LAMBDA_STD),
        'diff_lq2': nrm(ks[17], (N_LAYERS_B, DIFF_DH), LAMBDA_STD),
        'diff_lk2': nrm(ks[18], (N_LAYERS_B, DIFF_DH), LAMBDA_STD),
        'diff_subln_g': 1.0 + nrm(ks[19], (N_LAYERS_B, 2 * DIFF_DH), 0.02),
        'ffn_w_gu': nrm(ks[20], (DEPTH, D_MODEL, 2 * FFN_HIDDEN), D_MODEL ** -0.5),
        'ffn_w_down': nrm(ks[21], (DEPTH, FFN_HIDDEN, D_MODEL), FFN_HIDDEN ** -0.5),
    }


def reference(x, c, ctx, c_ctx, ada_w, ada_b, norm_g, mlstm_w_in, mlstm_gate_b, mlstm_head_g, mlstm_w_out,
              diff_w_in, diff_w_out, diff_q_g, diff_k_g, diff_lq1, diff_lk1, diff_lq2, diff_lk2, diff_subln_g,
              ffn_w_gu, ffn_w_down):
    S = x.shape[1]
    ROWS = S // GRID_W
    row = jnp.repeat(jnp.arange(ROWS), GRID_W)
    col = jnp.tile(jnp.arange(GRID_W), ROWS)
    n_freq = DIFF_DH // 4
    freqs = ROPE_BASE ** (-jnp.arange(n_freq, dtype=jnp.float32) / n_freq)
    ang = jnp.stack([row, col], axis=-1).astype(jnp.float32)[:, :, None] * freqs
    cos, sin = jnp.cos(ang), jnp.sin(ang)

    for i in range(DEPTH):
        update_ctx = i < DEPTH - 1
        mx = [m[:, None, :] for m in jnp.split(jax.nn.silu(c) @ ada_w[i] + ada_b[i], 6, axis=-1)]
        mc = jnp.split(jax.nn.silu(c_ctx) @ ada_w[i] + ada_b[i], 6, axis=-1)
        hx = modulate(rms_norm(x, norm_g[i, 0]), mx[0], mx[1])
        hc = modulate(rms_norm(ctx, norm_g[i, 0]), mc[0], mc[1])
        j = i // N_MIXERS
        if i % N_MIXERS == 0:
            ox, oc = mlstm_mixer(hx, hc, mlstm_w_in[j], mlstm_gate_b[j], mlstm_head_g[j], mlstm_w_out[j], update_ctx)
        else:
            lam_init = 0.8 - 0.6 * math.exp(-0.3 * i)
            ox, oc = diff_attn_mixer(hx, hc, diff_w_in[j], diff_w_out[j], diff_q_g[j], diff_k_g[j],
                                     diff_lq1[j], diff_lk1[j], diff_lq2[j], diff_lk2[j], diff_subln_g[j],
                                     lam_init, cos, sin, update_ctx)
        x = x + mx[2] * ox
        hx2 = modulate(rms_norm(x, norm_g[i, 1]), mx[3], mx[4])
        x = x + mx[5] * swiglu(hx2, ffn_w_gu[i], ffn_w_down[i])
        if update_ctx:
            ctx = ctx + mc[2] * oc
            hc2 = modulate(rms_norm(ctx, norm_g[i, 1]), mc[3], mc[4])
            ctx = ctx + mc[5] * swiglu(hc2, ffn_w_gu[i], ffn_w_down[i])
    return x
```

```cpp
#include <hip/hip_runtime.h>
#include <cstdio>
#include <cstdint>
typedef __bf16 bf16x2_hw __attribute__((ext_vector_type(2)));
typedef float f32x2_hw __attribute__((ext_vector_type(2)));
__device__ __forceinline__ unsigned cvt_pk_bf16_hw(float lo, float hi) { const f32x2_hw v = {lo, hi}; const bf16x2_hw r = __builtin_convertvector(v, bf16x2_hw); return __builtin_bit_cast(unsigned, r); }
__device__ __forceinline__ int lane_id() { int l; asm volatile("v_mbcnt_lo_u32_b32 %0, -1, 0\n\tv_mbcnt_hi_u32_b32 %0, -1, %0" : "=v"(l)); return l & 63; }
typedef _Float16 f16x2_hw __attribute__((ext_vector_type(2)));
__device__ __forceinline__ unsigned pkh2(float lo, float hi) { lo = __builtin_amdgcn_fmed3f(lo, -65000.0f, 65000.0f); hi = __builtin_amdgcn_fmed3f(hi, -65000.0f, 65000.0f);
    const f32x2_hw v = {lo, hi}; const f16x2_hw r = __builtin_convertvector(v, f16x2_hw); return __builtin_bit_cast(unsigned, r); }
__device__ __forceinline__ float h_lo(unsigned w) { const f16x2_hw r = __builtin_bit_cast(f16x2_hw, w); return (float)r[0]; }
__device__ __forceinline__ float h_hi(unsigned w) { const f16x2_hw r = __builtin_bit_cast(f16x2_hw, w); return (float)r[1]; }
namespace pg8 {
#define PG8_LAS __attribute__((address_space(3)))
typedef unsigned short bf16_t;
typedef short bf16x8 __attribute__((ext_vector_type(8)));
typedef float f32x4 __attribute__((ext_vector_type(4)));
typedef unsigned u32x4 __attribute__((ext_vector_type(4)));
constexpr int BM = 256, BK = 64, HALF = 128, HTB = HALF * BK * 2  , STAGE_BYTES = 8 * HTB, NXCD = 8, WGM = 8;

__host__ __device__ __forceinline__ int lds_byte(int r, int c) { const int st = (r >> 4) * 2 + (c >> 5), rr = r & 15, cc = c & 31, ob = rr * 64 + cc * 2; return st * 1024 + (ob ^ (((ob >> 9) & 1) << 5)); }
__host__ __device__ __forceinline__ void stage_rc(int b, int& R, int& C) { const int st = b / 1024, sb = b % 1024, swz = sb ^ (((sb >> 9) & 1) << 5); R = (st >> 1) * 16 + swz / 64; C = (st & 1) * 32 + (swz % 64) / 2; }
__host__ __device__ __forceinline__ int perm32(int rho) { const int n = rho >> 4, i = rho & 15; return 8 * (i >> 2) + 4 * n + (i & 3); }

struct Unit { int pm, pn, ks; };
struct Gemm { const bf16_t* A; const bf16_t* Bt; int M, N, K, ld; };

struct StaticOrder {
    int nM, nN, nwg, G, c;
    __host__ __device__ void init(int M, int N, int G_, int c_) { nM = M / BM; nN = N / BM; nwg = nM * nN; G = G_; c = c_; }
    __host__ __device__ bool next(int i, Unit& u) const {
        const long L = (long)i * G + c; if (L >= nwg) return false;
        int wgid = (int)L; { const int q = nwg / NXCD, r = nwg % NXCD, xcd = wgid % NXCD, off = wgid / NXCD; wgid = (xcd < r ? xcd * (q + 1) : r * (q + 1) + (xcd - r) * q) + off; }
        const int nig = WGM * nN, gid = wgid / nig, fm = gid * WGM, gsz = (nM - fm) < WGM ? (nM - fm) : WGM;
        u.pm = fm + ((wgid % nig) % gsz); u.pn = (wgid % nig) / gsz; u.ks = 0; return true;
    }
    __device__ __forceinline__ void a_ready(const Unit&) const {}
    __device__ __forceinline__ void done(const Unit&) const {}
};
struct PanelOrder {
    int nM, nN, nwg, G, c;
    __host__ __device__ void init(int M, int N, int G_, int c_) { nM = M / BM; nN = N / BM; nwg = nM * nN; G = G_; c = c_; }
    __host__ __device__ bool next(int i, Unit& u) const {
        const long L = (long)i * G + c; if (L >= nwg) return false;
        int wgid = (int)L; { const int q = nwg / NXCD, r = nwg % NXCD, xcd = wgid % NXCD, off = wgid / NXCD; wgid = (xcd < r ? xcd * (q + 1) : r * (q + 1) + (xcd - r) * q) + off; }
        u.pm = wgid / nN; u.pn = wgid % nN; u.ks = 0; return true;
    }
    __device__ __forceinline__ void a_ready(const Unit&) const {}
    __device__ __forceinline__ void done(const Unit&) const {}
};
struct SplitOrder {
    int nM, nN, nS, G, c;
    __host__ __device__ void init(int M, int N, int nS_, int G_, int c_) { nM = M / BM; nN = N / BM; nS = nS_; G = G_; c = c_; }
    __host__ __device__ bool next(int i, Unit& u) const {
        const int L = i * G + c; if (L >= nM * nN * nS) return false;
        u.ks = L / (nM * nN); const int rem = L % (nM * nN); u.pn = rem / nM; u.pm = rem % nM; return true;
    }
    __device__ __forceinline__ void a_ready(const Unit&) const {}
    __device__ __forceinline__ void done(const Unit&) const {}
};


__device__ __forceinline__ unsigned cvt_pk_bf16(float lo, float hi) { return cvt_pk_bf16_hw(lo, hi); }
typedef float f32x2 __attribute__((ext_vector_type(2)));
__device__ __forceinline__ float softcap15(float x) { return 15.0f * tanhf(x * (1.0f / 15.0f)); }
__device__ __forceinline__ float log_sigmoid(float x) { return fminf(x, 0.f) - log1pf(__expf(-fabsf(x))); }
struct EpiProj {
    static constexpr bool PERM = true, AFTER_DRAIN = false;
    bf16_t* O; int ldc; float* gates; const float* gate_b; int mlstm;
    int attn; const float* qg; const float* kg; PG8_LAS float* P; int nrope;
    __device__ __forceinline__ void operator()(const f32x4 (&acc)[2][2][4][2], const Unit& u, int wr, int wc, int fr, int fq) const {
        const int row0 = u.pm * BM + wr * 64 + fr;
        if (attn && u.pn < 16) {
            const bool isq = u.pn < 8; const float* G = isq ? qg : kg;
            const int half = wc >> 1, fb = 16 * (wc & 1) + 4 * fq;
#pragma unroll
            for (int ai = 0; ai < 2; ++ai)
#pragma unroll
                for (int m = 0; m < 4; ++m)
#pragma unroll
                    for (int bj = 0; bj < 2; ++bj) { const f32x4 a = acc[ai][bj][m][0], b = acc[ai][bj][m][1];
                        float s = (a[0] * a[0] + a[1] * a[1]) + (a[2] * a[2] + a[3] * a[3]) + (b[0] * b[0] + b[1] * b[1]) + (b[2] * b[2] + b[3] * b[3]);
                        s += __shfl_xor(s, 16); s += __shfl_xor(s, 32);
                        if (fq == 0) P[(ai * HALF + wr * 64 + m * 16 + fr) * 8 + bj * 4 + wc] = s; }
            asm volatile("s_waitcnt lgkmcnt(0)" ::: "memory"); __builtin_amdgcn_s_barrier(); asm volatile("" ::: "memory");
            const f32x4 g1 = *(const f32x4*)(G + half * 64 + fb), g2 = *(const f32x4*)(G + half * 64 + 32 + fb);
            float frq[4];
#pragma unroll
            for (int i = 0; i < 4; ++i) frq[i] = exp2f(-(float)(fb + i) * (13.287712379549449f / 32.0f)) * 0.15915494309189535f;
            const float qs = isq ? (0.08838834764831845f * 1.4426950408889634f) : 1.0f;
            const int col0 = u.pn * BM + wc * 32 + 8 * fq;
#pragma unroll
            for (int ai = 0; ai < 2; ++ai)
#pragma unroll
                for (int m = 0; m < 4; ++m) { const int rl = ai * HALF + wr * 64 + m * 16 + fr, row = u.pm * BM + rl;
                    float cs[4], sn[4];
                    if (row < nrope) { const int sq = row & 4095; const float pos = (float)(half ? (sq & 63) : (sq >> 6));
#pragma unroll
                        for (int i = 0; i < 4; ++i) { float rev = pos * frq[i]; rev -= rintf(rev); cs[i] = __builtin_amdgcn_cosf(rev); sn[i] = __builtin_amdgcn_sinf(rev); } }
                    else {
#pragma unroll
                        for (int i = 0; i < 4; ++i) { cs[i] = 1.f; sn[i] = 0.f; } }
                    bf16_t* rowp = O + (size_t)row * ldc + col0;
#pragma unroll
                    for (int bj = 0; bj < 2; ++bj) { const f32x4 p4 = *(const PG8_LAS f32x4*)(P + rl * 8 + bj * 4);
                        const float rs = __builtin_amdgcn_rsqf(((p4[0] + p4[1]) + (p4[2] + p4[3])) * (1.0f / 128.0f) + 1e-6f) * qs;
                        const f32x4 v0 = acc[ai][bj][m][0], v1 = acc[ai][bj][m][1];
                        const float x1[4] = {v0[0], v0[2], v1[0], v1[2]}, x2[4] = {v0[1], v0[3], v1[1], v1[3]};
                        float o1[4], o2[4];
#pragma unroll
                        for (int i = 0; i < 4; ++i) { const float y1 = x1[i] * rs * g1[i], y2 = x2[i] * rs * g2[i]; o1[i] = y1 * cs[i] - y2 * sn[i]; o2[i] = y2 * cs[i] + y1 * sn[i]; }
                        u32x4 w; w.x = cvt_pk_bf16(o1[0], o2[0]); w.y = cvt_pk_bf16(o1[1], o2[1]); w.z = cvt_pk_bf16(o1[2], o2[2]); w.w = cvt_pk_bf16(o1[3], o2[3]);
                        *(u32x4*)(rowp + bj * HALF) = w; } }
            return;
        }
        if (mlstm && u.pn == 24) {
            if (wc == 0) {
                const f32x4 b0 = *(const f32x4*)(gate_b + 8 * fq), b1 = *(const f32x4*)(gate_b + 8 * fq + 4);
#pragma unroll
                for (int ai = 0; ai < 2; ++ai)
#pragma unroll
                    for (int m = 0; m < 4; ++m) { float* gp = gates + (size_t)(row0 + ai * HALF + m * 16) * 32 + 8 * fq;
                        f32x4 v0 = acc[ai][0][m][0] + b0, v1 = acc[ai][0][m][1] + b1;
#pragma unroll
                        for (int j = 0; j < 4; ++j) { v0[j] = softcap15(v0[j]); v1[j] = softcap15(v1[j]); if (fq & 1) { v0[j] = log_sigmoid(v0[j]); v1[j] = log_sigmoid(v1[j]); } }
                        *(f32x4*)gp = v0; *(f32x4*)(gp + 4) = v1; }
            }
            return;
        }
        const float sc = (mlstm && u.pn < 4) ? 0.08838834764831845f : 1.0f;
        const int col0 = u.pn * BM + wc * 32 + 8 * fq;
#pragma unroll
        for (int ai = 0; ai < 2; ++ai)
#pragma unroll
            for (int m = 0; m < 4; ++m) { bf16_t* rowp = O + (size_t)(row0 + ai * HALF + m * 16) * ldc + col0;
#pragma unroll
                for (int bj = 0; bj < 2; ++bj) { const f32x4 v0 = acc[ai][bj][m][0] * sc, v1 = acc[ai][bj][m][1] * sc;
                    u32x4 w; w.x = cvt_pk_bf16(v0[0], v0[1]); w.y = cvt_pk_bf16(v0[2], v0[3]); w.z = cvt_pk_bf16(v1[0], v1[1]); w.w = cvt_pk_bf16(v1[2], v1[3]);
                    *(u32x4*)(rowp + bj * HALF) = w; } }
    }
};
struct EpiResid {
    static constexpr bool PERM = true, AFTER_DRAIN = false;
    const unsigned short* base; void* out; const float* gate; int fin;
    __device__ __forceinline__ void operator()(const f32x4 (&acc)[2][2][4][2], const Unit& u, int wr, int wc, int fr, int fq) const {
        const int row0 = u.pm * BM + wr * 64 + fr, col0 = u.pn * BM + wc * 32 + 8 * fq;
        const float* gp = gate + (size_t)(u.pm < 64 ? (u.pm >> 4) : 4) * 12288 + col0;
        f32x4 gv[2][2];
#pragma unroll
        for (int bj = 0; bj < 2; ++bj)
#pragma unroll
            for (int n = 0; n < 2; ++n) gv[bj][n] = *(const f32x4*)(gp + bj * HALF + 4 * n);
#pragma unroll
        for (int ai = 0; ai < 2; ++ai)
#pragma unroll
            for (int m = 0; m < 4; ++m) { const size_t off = (size_t)(row0 + ai * HALF + m * 16) * 2048 + col0;
                u32x4 bs[2];
#pragma unroll
                for (int bj = 0; bj < 2; ++bj) bs[bj] = *(const u32x4*)(base + off + bj * HALF);
#pragma unroll
                for (int bj = 0; bj < 2; ++bj) {
                    f32x4 r0, r1;
                    r0[0] = h_lo(bs[bj].x); r0[1] = h_hi(bs[bj].x); r0[2] = h_lo(bs[bj].y); r0[3] = h_hi(bs[bj].y);
                    r1[0] = h_lo(bs[bj].z); r1[1] = h_hi(bs[bj].z); r1[2] = h_lo(bs[bj].w); r1[3] = h_hi(bs[bj].w);
                    r0 += gv[bj][0] * acc[ai][bj][m][0]; r1 += gv[bj][1] * acc[ai][bj][m][1];
                    if (fin) { float* op = (float*)out + off + bj * HALF; *(f32x4*)op = r0; *(f32x4*)(op + 4) = r1; }
                    else { u32x4 w; w.x = pkh2(r0[0], r0[1]); w.y = pkh2(r0[2], r0[3]); w.z = pkh2(r1[0], r1[1]); w.w = pkh2(r1[2], r1[3]);
                        *(u32x4*)((unsigned short*)out + off + bj * HALF) = w; } }
                asm volatile("" ::: "memory"); }
    }
};
struct EpiResidNorm {
    static constexpr bool PERM = true, AFTER_DRAIN = false;
    const unsigned short* base; unsigned short* out; const float* gate;
    bf16_t* hn; const float* ngain; const float* nmod;
    unsigned long long* xbuf; unsigned tag; unsigned* tmo; PG8_LAS float* P;
    __device__ __forceinline__ void operator()(const f32x4 (&acc)[2][2][4][2], const Unit& u, int wr, int wc, int fr, int fq) const {
        const int row0 = u.pm * BM + wr * 64 + fr, col0 = u.pn * BM + wc * 32 + 8 * fq;
        const int mrow = u.pm < 64 ? (u.pm >> 4) : 4;
        f32x4 xn[2][2][4][2];
        {
            const float* gp = gate + (size_t)mrow * 12288 + col0;
            f32x4 gv[2][2];
#pragma unroll
            for (int bj = 0; bj < 2; ++bj)
#pragma unroll
                for (int n = 0; n < 2; ++n) gv[bj][n] = *(const f32x4*)(gp + bj * HALF + 4 * n);
#pragma unroll
            for (int ai = 0; ai < 2; ++ai)
#pragma unroll
                for (int m = 0; m < 4; ++m) { const size_t off = (size_t)(row0 + ai * HALF + m * 16) * 2048 + col0;
                    u32x4 bs[2]; float s = 0.f;
#pragma unroll
                    for (int bj = 0; bj < 2; ++bj) bs[bj] = *(const u32x4*)(base + off + bj * HALF);
#pragma unroll
                    for (int bj = 0; bj < 2; ++bj) {
                        f32x4 r0, r1;
                        r0[0] = h_lo(bs[bj].x); r0[1] = h_hi(bs[bj].x); r0[2] = h_lo(bs[bj].y); r0[3] = h_hi(bs[bj].y);
                        r1[0] = h_lo(bs[bj].z); r1[1] = h_hi(bs[bj].z); r1[2] = h_lo(bs[bj].w); r1[3] = h_hi(bs[bj].w);
                        r0 += gv[bj][0] * acc[ai][bj][m][0]; r1 += gv[bj][1] * acc[ai][bj][m][1];
                        u32x4 w; w.x = pkh2(r0[0], r0[1]); w.y = pkh2(r0[2], r0[3]); w.z = pkh2(r1[0], r1[1]); w.w = pkh2(r1[2], r1[3]);
                        *(u32x4*)(out + off + bj * HALF) = w;
                        xn[ai][bj][m][0] = r0; xn[ai][bj][m][1] = r1;
                        s += ((r0[0] * r0[0] + r0[1] * r0[1]) + (r0[2] * r0[2] + r0[3] * r0[3])) + ((r1[0] * r1[0] + r1[1] * r1[1]) + (r1[2] * r1[2] + r1[3] * r1[3])); }
                    s += __shfl_xor(s, 16); s += __shfl_xor(s, 32);
                    if (fq == 0) P[(ai * HALF + wr * 64 + m * 16 + fr) * 4 + wc] = s;
                    asm volatile("" ::: "memory"); }
        }
        asm volatile("s_waitcnt lgkmcnt(0)" ::: "memory"); __builtin_amdgcn_s_barrier(); asm volatile("" ::: "memory");
        const int wid = wr * 4 + wc, lane = fq * 16 + fr, row = wid * 32 + (lane & 31);
        unsigned long long* slot = xbuf + ((size_t)(u.pm * BM + row) * 8);
        if (lane < 32) { const f32x4 p4 = *(const PG8_LAS f32x4*)(P + row * 4);
            __hip_atomic_store(slot + u.pn, ((unsigned long long)tag << 32) | (unsigned long long)__builtin_bit_cast(unsigned, (p4[0] + p4[1]) + (p4[2] + p4[3])), __ATOMIC_RELAXED, __HIP_MEMORY_SCOPE_AGENT);
            unsigned sp = 0u; float t;
            for (;;) { bool ok = true; t = 0.f;
#pragma unroll
                for (int k = 0; k < 8; ++k) { const unsigned long long w = __hip_atomic_load(slot + k, __ATOMIC_RELAXED, __HIP_MEMORY_SCOPE_AGENT); ok = ok && ((unsigned)(w >> 32) == tag); t += __builtin_bit_cast(float, (unsigned)w); }
                if (__builtin_amdgcn_ballot_w64(!ok) == 0ull) break;
                __builtin_amdgcn_s_sleep(1);
                if ((++sp & 255u) == 0u) { if (__hip_atomic_load(tmo, __ATOMIC_RELAXED, __HIP_MEMORY_SCOPE_AGENT)) break; if (sp > (1u << 20)) { __hip_atomic_store(tmo, 1u, __ATOMIC_RELAXED, __HIP_MEMORY_SCOPE_AGENT); break; } } }
            P[1024 + row] = 1.0f / sqrtf(t * (1.0f / 2048.0f) + 1e-6f); }
        asm volatile("s_waitcnt lgkmcnt(0)" ::: "memory"); __builtin_amdgcn_s_barrier(); asm volatile("" ::: "memory");
        f32x4 GG[2][2], SH[2][2];
        { const float* md = nmod + (size_t)mrow * 12288 + col0;
#pragma unroll
          for (int bj = 0; bj < 2; ++bj)
#pragma unroll
            for (int n = 0; n < 2; ++n) { const f32x4 g = *(const f32x4*)(ngain + col0 + bj * HALF + 4 * n), sc = *(const f32x4*)(md + 2048 + bj * HALF + 4 * n);
                GG[bj][n] = g * (sc + 1.0f); SH[bj][n] = *(const f32x4*)(md + bj * HALF + 4 * n); } }
#pragma unroll
        for (int ai = 0; ai < 2; ++ai)
#pragma unroll
            for (int m = 0; m < 4; ++m) { const int rl = ai * HALF + wr * 64 + m * 16 + fr; const float rs = P[1024 + rl];
                bf16_t* rowp = hn + (size_t)(u.pm * BM + rl) * 2048 + col0;
#pragma unroll
                for (int bj = 0; bj < 2; ++bj) { const f32x4 y0 = (xn[ai][bj][m][0] * rs) * GG[bj][0] + SH[bj][0], y1 = (xn[ai][bj][m][1] * rs) * GG[bj][1] + SH[bj][1];
                    u32x4 w; w.x = cvt_pk_bf16(y0[0], y0[1]); w.y = cvt_pk_bf16(y0[2], y0[3]); w.z = cvt_pk_bf16(y1[0], y1[1]); w.w = cvt_pk_bf16(y1[2], y1[3]);
                    *(u32x4*)(rowp + bj * HALF) = w; } }
    }
};
struct EpiSwiGLU {
    static constexpr bool PERM = true, AFTER_DRAIN = false;
    bf16_t* Hd; int ldh;
    __device__ __forceinline__ void operator()(const f32x4 (&acc)[2][2][4][2], const Unit& u, int wr, int wc, int fr, int fq) const {
        const int row0 = u.pm * BM + wr * 64 + fr, col0 = u.pn * HALF + wc * 32 + 8 * fq;
#pragma unroll
        for (int ai = 0; ai < 2; ++ai)
#pragma unroll
            for (int m = 0; m < 4; ++m) { float r[8];
#pragma unroll
                for (int n = 0; n < 2; ++n)
#pragma unroll
                    for (int j = 0; j < 4; ++j) { const float g = acc[ai][0][m][n][j], up = acc[ai][1][m][n][j]; r[4 * n + j] = g * __builtin_amdgcn_rcpf(1.0f + __expf(-g)) * up; }
                u32x4 w; w.x = cvt_pk_bf16(r[0], r[1]); w.y = cvt_pk_bf16(r[2], r[3]); w.z = cvt_pk_bf16(r[4], r[5]); w.w = cvt_pk_bf16(r[6], r[7]);
                *(u32x4*)(Hd + (size_t)(row0 + ai * HALF + m * 16) * ldh + col0) = w; }
    }
};

struct EpiSlab {
    static constexpr bool PERM = false, AFTER_DRAIN = false;
    float* slab; size_t ks_stride;
    __device__ __forceinline__ void operator()(const f32x4 (&acc)[2][2][4][2], const Unit& u, int wr, int wc, int fr, int fq) const {
        const int row0 = u.pm * BM + wr * 64 + fr, col0 = u.pn * BM + wc * 32 + 4 * fq;
        float* sp = slab + (size_t)u.ks * ks_stride;
#pragma unroll
        for (int ai = 0; ai < 2; ++ai)
#pragma unroll
            for (int m = 0; m < 4; ++m) { const size_t off = (size_t)(row0 + ai * HALF + m * 16) * 2048 + col0;
#pragma unroll
                for (int bj = 0; bj < 2; ++bj)
#pragma unroll
                    for (int n = 0; n < 2; ++n) *(f32x4*)(sp + off + bj * HALF + n * 16) = acc[ai][bj][m][n]; }
    }
};

template <class Epi, class Sched, bool ALIGN_EPI = false, bool SP2 = false>
__device__ __forceinline__ void gemm_phase(PG8_LAS unsigned char* lds, const Gemm g, const Sched& S, const Epi& E, const int wave_in) {
    const int lane = lane_id(), wid = wave_in, tid = wid * 64 + lane,
              wr = wid >> 2, wc = wid & 3, fr = lane & 15, fq = lane >> 4;
    const int K = g.ld, nt = g.K / BK;
    unsigned voffA[2], voffB[2];
#pragma unroll
    for (int i = 0; i < 2; ++i) { int R, C; stage_rc(tid * 16 + i * 8192, R, C); const int Rb = Epi::PERM ? ((R & ~31) + perm32(R & 31)) : R;
        voffA[i] = (unsigned)(R * K + C) * 2u; voffB[i] = (unsigned)(Rb * K + C) * 2u; }
    const size_t kstep = (size_t)(BK * 2);
    const size_t hstep = (size_t)HALF * K * 2;
    const size_t tstep = 2 * hstep;
    const unsigned ldsw = (unsigned)wid * 1024u;
    const int aoff = lds_byte(wr * 64 + fr, fq * 8), boff = lds_byte(wc * 32 + fr, fq * 8);
#define PG8_SA(b, h) (((b) * 2 + (h)) * HTB)
#define PG8_SB(b, h) ((4 + (b) * 2 + (h)) * HTB)
#define PG8_STAGE(bufoff, gbase, voff) do { _Pragma("unroll") for (int _i = 0; _i < 2; ++_i) \
        __builtin_amdgcn_global_load_lds((const unsigned*)((const char*)(gbase) + (voff)[_i]), (PG8_LAS unsigned*)(lds + (bufoff) + ldsw + _i * 8192), 16, 0, 0); } while (0)
#define PG8_LDA(dst, b, h) do { _Pragma("unroll") for (int m = 0; m < 4; ++m) _Pragma("unroll") for (int k = 0; k < 2; ++k) dst[m][k] = *(const PG8_LAS bf16x8*)(lds + PG8_SA(b, h) + aoff + m * 2048 + k * 1024); } while (0)
#define PG8_LDB(dst, b, h) do { _Pragma("unroll") for (int n = 0; n < 2; ++n) _Pragma("unroll") for (int k = 0; k < 2; ++k) dst[n][k] = *(const PG8_LAS bf16x8*)(lds + PG8_SB(b, h) + boff + n * 2048 + k * 1024); } while (0)
#define PG8_MMA(ai, bj, At, Bt) do { __builtin_amdgcn_s_setprio(1); _Pragma("unroll") for (int m = 0; m < 4; ++m) _Pragma("unroll") for (int n = 0; n < 2; ++n) _Pragma("unroll") for (int k = 0; k < 2; ++k) \
        acc[ai][bj][m][n] = __builtin_amdgcn_mfma_f32_16x16x32_bf16(Bt[n][k], At[m][k], acc[ai][bj][m][n], 0, 0, 0); __builtin_amdgcn_s_setprio(0); } while (0)
#define PG8_WAIT_V(n) asm volatile("s_waitcnt vmcnt(" #n ")" ::: "memory")
#define PG8_WAIT_L(n) asm volatile("s_waitcnt lgkmcnt(" #n ")" ::: "memory")
#define PG8_BAR __builtin_amdgcn_s_barrier()
#define PG8_SCHED __builtin_amdgcn_sched_barrier(0)
    Unit cur, nxt; int ui = 0;
    if (!S.next(0, cur)) return;
    f32x4 acc[2][2][4][2];
#pragma unroll
    for (int a = 0; a < 2; ++a)
#pragma unroll
        for (int b = 0; b < 2; ++b)
#pragma unroll
            for (int m = 0; m < 4; ++m)
#pragma unroll
                for (int n = 0; n < 2; ++n) acc[a][b][m][n] = (f32x4){0.f, 0.f, 0.f, 0.f};
    bf16x8 At[4][2], B0[2][2], B1[2][2];
    const size_t kspl = (size_t)g.K * 2;
    const char* cA = (const char*)g.A + (size_t)cur.pm * tstep + (size_t)cur.ks * kspl; const char* cB = (const char*)g.Bt + (size_t)cur.pn * tstep + (size_t)cur.ks * kspl;
    S.a_ready(cur);
    if constexpr (SP2) {
        PG8_STAGE(PG8_SB(0, 0), cB, voffB); PG8_STAGE(PG8_SB(0, 1), cB + hstep, voffB); PG8_STAGE(PG8_SA(0, 0), cA, voffA); PG8_STAGE(PG8_SA(0, 1), cA + hstep, voffA);
        if (wr == 1) PG8_BAR;
        PG8_WAIT_V(2); PG8_BAR;
        PG8_STAGE(PG8_SB(1, 0), cB + kstep, voffB); PG8_STAGE(PG8_SA(1, 0), cA + kstep, voffA); PG8_STAGE(PG8_SB(1, 1), cB + hstep + kstep, voffB);
        PG8_WAIT_V(6); PG8_BAR;
    } else {
        PG8_STAGE(PG8_SB(0, 0), cB, voffB); PG8_STAGE(PG8_SA(0, 0), cA, voffA); PG8_STAGE(PG8_SB(0, 1), cB + hstep, voffB); PG8_STAGE(PG8_SA(0, 1), cA + hstep, voffA);
        if (wr == 1) PG8_BAR;
        PG8_WAIT_V(4); PG8_BAR;
        PG8_STAGE(PG8_SB(1, 0), cB + kstep, voffB); PG8_STAGE(PG8_SA(1, 0), cA + kstep, voffA); PG8_STAGE(PG8_SB(1, 1), cB + hstep + kstep, voffB);
        PG8_WAIT_V(6); PG8_BAR;
    }
    for (;;) {
        const bool has_next = S.next(ui + 1, nxt);
        const char* nA = has_next ? (const char*)g.A + (size_t)nxt.pm * tstep + (size_t)nxt.ks * kspl : cA; const char* nB = has_next ? (const char*)g.Bt + (size_t)nxt.pn * tstep + (size_t)nxt.ks * kspl : cB;
        for (int t = 0; t < nt; t += 2) {
            const bool last = (t == nt - 2);
            const char* a1 = cA + (size_t)(t + 1) * kstep;
            const char* a2 = last ? nA : cA + (size_t)(t + 2) * kstep; const char* b2 = last ? nB : cB + (size_t)(t + 2) * kstep;
            const char* a3 = a2 + kstep; const char* b3 = b2 + kstep;
            if (last && has_next) S.a_ready(nxt);
            if constexpr (SP2) {
            PG8_LDB(B0, 0, 0); PG8_LDB(B1, 0, 1); PG8_SCHED; PG8_LDA(At, 0, 0); PG8_STAGE(PG8_SA(1, 1), a1 + hstep, voffA);
            PG8_WAIT_V(8); PG8_WAIT_L(0); PG8_BAR; PG8_MMA(0, 0, At, B0); PG8_MMA(0, 1, At, B1); PG8_BAR; PG8_SCHED;
            PG8_LDA(At, 0, 1); PG8_STAGE(PG8_SB(0, 0), b2, voffB); PG8_STAGE(PG8_SB(0, 1), b2 + hstep, voffB); PG8_STAGE(PG8_SA(0, 0), a2, voffA);
            PG8_WAIT_V(8); PG8_WAIT_L(0); PG8_BAR; PG8_MMA(1, 0, At, B0); PG8_MMA(1, 1, At, B1); PG8_BAR; PG8_SCHED;
            PG8_LDB(B0, 1, 0); PG8_LDB(B1, 1, 1); PG8_SCHED; PG8_LDA(At, 1, 0); PG8_STAGE(PG8_SA(0, 1), a2 + hstep, voffA);
            PG8_WAIT_V(8); PG8_WAIT_L(0); PG8_BAR; PG8_MMA(0, 0, At, B0); PG8_MMA(0, 1, At, B1); PG8_BAR; PG8_SCHED;
            PG8_LDA(At, 1, 1); PG8_STAGE(PG8_SB(1, 0), b3, voffB); PG8_STAGE(PG8_SB(1, 1), b3 + hstep, voffB); PG8_STAGE(PG8_SA(1, 0), a3, voffA);
            PG8_WAIT_V(8); PG8_WAIT_L(0); PG8_BAR; PG8_MMA(1, 0, At, B0); PG8_MMA(1, 1, At, B1); PG8_BAR; PG8_SCHED;
            } else {
            PG8_LDB(B0, 0, 0); PG8_SCHED; PG8_LDA(At, 0, 0); PG8_STAGE(PG8_SA(1, 1), a1 + hstep, voffA);
            PG8_WAIT_L(8); PG8_BAR; PG8_WAIT_L(0); PG8_MMA(0, 0, At, B0); PG8_BAR; PG8_SCHED;
            PG8_LDB(B1, 0, 1); PG8_STAGE(PG8_SB(0, 0), b2, voffB);
            PG8_BAR; PG8_WAIT_L(0); PG8_MMA(0, 1, At, B1); PG8_BAR;
            PG8_LDA(At, 0, 1); PG8_STAGE(PG8_SA(0, 0), a2, voffA);
            PG8_BAR; PG8_WAIT_L(0); PG8_MMA(1, 0, At, B0); PG8_BAR; PG8_SCHED;
            PG8_STAGE(PG8_SB(0, 1), b2 + hstep, voffB);
            PG8_WAIT_V(6); PG8_BAR; PG8_MMA(1, 1, At, B1); PG8_BAR;
            PG8_LDB(B0, 1, 0); PG8_SCHED; PG8_LDA(At, 1, 0); PG8_STAGE(PG8_SA(0, 1), a2 + hstep, voffA);
            PG8_WAIT_L(8); PG8_BAR; PG8_WAIT_L(0); PG8_MMA(0, 0, At, B0); PG8_BAR; PG8_SCHED;
            PG8_LDB(B1, 1, 1); PG8_STAGE(PG8_SB(1, 0), b3, voffB);
            PG8_BAR; PG8_WAIT_L(0); PG8_MMA(0, 1, At, B1); PG8_BAR;
            PG8_LDA(At, 1, 1); PG8_STAGE(PG8_SA(1, 0), a3, voffA);
            PG8_BAR; PG8_WAIT_L(0); PG8_MMA(1, 0, At, B0); PG8_BAR; PG8_SCHED;
            PG8_STAGE(PG8_SB(1, 1), b3 + hstep, voffB);
            PG8_WAIT_V(6); PG8_BAR; PG8_MMA(1, 1, At, B1); PG8_BAR;
            }
        }
        if constexpr (ALIGN_EPI) { if (wr == 0) PG8_BAR; }
        if constexpr (!Epi::AFTER_DRAIN) { E(acc, cur, wr, wc, fr, fq); S.done(cur); }
        if (!has_next) break;
#pragma unroll
        for (int a = 0; a < 2; ++a)
#pragma unroll
            for (int b = 0; b < 2; ++b)
#pragma unroll
                for (int m = 0; m < 4; ++m)
#pragma unroll
                    for (int n = 0; n < 2; ++n) acc[a][b][m][n] = (f32x4){0.f, 0.f, 0.f, 0.f};
        cur = nxt; cA = nA; cB = nB; ++ui;
        if constexpr (ALIGN_EPI) { if (wr == 1) PG8_BAR; }
    }
    PG8_WAIT_V(0);
    if constexpr (!ALIGN_EPI) { if (wr == 0) PG8_BAR; }
    PG8_BAR;
    if constexpr (Epi::AFTER_DRAIN) { E.fused(acc, cur, wr, wc, fr, fq, lds, wid, lane); S.done(cur); }
#undef PG8_SA
#undef PG8_SB
#undef PG8_STAGE
#undef PG8_LDA
#undef PG8_LDB
#undef PG8_MMA
#undef PG8_WAIT_V
#undef PG8_WAIT_L
#undef PG8_BAR
#undef PG8_SCHED
}
}

#ifndef PG8_SP2
#define PG8_SP2 true
#endif
#ifndef PG8_ALIGN
#define PG8_ALIGN true
#endif
constexpr int NWAVES = 8;
constexpr int DM = 2048, NB = 4, SEQ = 4096, CTXL = 256, DEPTH = 4;
constexpr int ML = NB * SEQ, MC = NB * CTXL, MT = ML + MC;
constexpr int NHEAD = 8, DKH = 128, DVH = 256;
constexpr int MIN_REAL = 6176, MIN_PAD = 6400, AIN = 6144, LDP = 6400;
constexpr int FFH = 5632, NGU = 2 * FFH;
constexpr float EPS = 1e-6f;
constexpr int N_PHASES = 1 + 8 * DEPTH;
#ifndef DBG_LASTL
#define DBG_LASTL (DEPTH - 1)
#endif
#ifndef DBG_CTXUPD
#define DBG_CTXUPD DEPTH
#endif
constexpr int CTXUPD = DBG_CTXUPD;
constexpr int LASTL = DBG_LASTL;

constexpr size_t MiB = 1u << 20;
constexpr size_t WS_CTL = 0, CTL_ZERO_BYTES = 1 * MiB;
constexpr size_t WS_MOD = 1 * MiB;
constexpr size_t WS_GATES = 2 * MiB;
constexpr size_t WS_W_MIN = 8 * MiB;
constexpr size_t WS_W_MOUT = 58 * MiB;
constexpr size_t WS_W_AIN = 74 * MiB;
constexpr size_t WS_W_AOUT = 122 * MiB;
constexpr size_t WS_W_GU = 138 * MiB;
constexpr size_t WS_W_DN = 314 * MiB;
constexpr size_t WS_X = 402 * MiB;
constexpr size_t WS_HN = 538 * MiB;
constexpr size_t WS_OB = 606 * MiB;
constexpr size_t WS_PROJ = 674 * MiB;
constexpr size_t WS_HID = 887 * MiB;
constexpr size_t WS_HF = WS_HID, WS_HB = WS_HID + 136 * MiB;
constexpr size_t WS_SLAB = 1160 * MiB;
constexpr int KSPLIT = 4;
constexpr size_t WS_END = 1192 * MiB;
static_assert(WS_W_MIN + (size_t)2 * MIN_PAD * DM * 2 <= WS_W_MOUT && WS_W_AIN + (size_t)2 * AIN * DM * 2 <= WS_W_AOUT && WS_W_GU + (size_t)4 * NGU * DM * 2 <= WS_W_DN && WS_W_DN + (size_t)4 * DM * FFH * 2 <= WS_X, "ws map (weights)");
static_assert(WS_X + (size_t)MT * DM * 4 <= WS_HN && WS_HN + (size_t)MT * DM * 2 <= WS_OB && WS_OB + (size_t)MT * DM * 2 <= WS_PROJ && WS_PROJ + (size_t)MT * LDP * 2 <= WS_HID && WS_HB + (size_t)MT * DM * 4 <= WS_SLAB && WS_HID + (size_t)MT * FFH * 2 <= WS_SLAB && WS_SLAB + (size_t)KSPLIT * MC * DM * 4 <= WS_END, "ws map (activations)");
constexpr int CW_Q0 = 64;
constexpr int CW_BAR = 4096;
constexpr int CW_XTMO = 32;
constexpr size_t WS_XBUF = 5 * MiB;

constexpr int RING_BYTES = 147456;
constexpr int MISC_OFF = RING_BYTES;
constexpr int LDS_BYTES = RING_BYTES + 256;

#define GAS __attribute__((address_space(1)))
#define CAS __attribute__((address_space(4)))
#define LAS __attribute__((address_space(3)))
typedef unsigned short bf16;
typedef unsigned v4u __attribute__((ext_vector_type(4)));
typedef unsigned v2u __attribute__((ext_vector_type(2)));
typedef float f32x4 __attribute__((ext_vector_type(4)));
typedef float f32x16 __attribute__((ext_vector_type(16)));
typedef short bf16x8 __attribute__((ext_vector_type(8)));
typedef short s16x4 __attribute__((ext_vector_type(4)));
#define LDS_WAIT() asm volatile("s_waitcnt lgkmcnt(0)" ::: "memory")
#define VM_WAIT() asm volatile("s_waitcnt vmcnt(0)" ::: "memory")
__device__ __forceinline__ unsigned pk2(float lo, float hi) { return cvt_pk_bf16_hw(lo, hi); }
__device__ __forceinline__ unsigned f2bf(float f) { return cvt_pk_bf16_hw(f, f) & 0xffffu; }
__device__ __forceinline__ float bf_lo(unsigned w) { return __builtin_bit_cast(float, w << 16); }
__device__ __forceinline__ float bf_hi(unsigned w) { return __builtin_bit_cast(float, w & 0xffff0000u); }
__device__ __forceinline__ int opaque(int v) { asm volatile("" : "+v"(v)); return v; }
__device__ __forceinline__ float wave_sum(float v) {
#pragma unroll
    for (int o = 1; o < 64; o <<= 1) v += __shfl_xor(v, o);
    return v;
}

#define XB_TMO      128
#define XB_XCNT(j)  (256  + 64 * (j))
#define XB_XSUB(j)  (1280 + 64 * (j))
#define XB_XGEN(j)  (2304 + 64 * (j))
#define XB_TOP      3328
#define XB_TOPGEN   3392
#define XCD_BAR_WORDS 3456
#define XB_SPIN_CAP (1u << 18)

__device__ __forceinline__ unsigned xb_ld(unsigned* p)              { return __hip_atomic_load(p, __ATOMIC_RELAXED, __HIP_MEMORY_SCOPE_AGENT); }
__device__ __forceinline__ unsigned xb_add(unsigned* p, unsigned v) { return __hip_atomic_fetch_add(p, v, __ATOMIC_RELAXED, __HIP_MEMORY_SCOPE_AGENT); }
__device__ __forceinline__ unsigned xb_xcc_id() { return (unsigned)__builtin_amdgcn_s_getreg((3 << 11) | 20) & 0xFu; }
#define XB_SPIN(cond, bar) do { unsigned _sp = 0; while (cond) { __builtin_amdgcn_s_sleep(1); \
    if ((++_sp & 255u) == 0u) { if (xb_ld(&(bar)[XB_TMO])) break; if (_sp > XB_SPIN_CAP) { atomicAdd(&(bar)[XB_TMO], 1u); break; } } } } while (0)

struct XcdBarrier {
    unsigned* bar; unsigned x; int wave;
    volatile LAS unsigned* st;
};

__device__ __forceinline__ XcdBarrier xcd_barrier_post(unsigned* bar, volatile LAS unsigned* st, int wave) {
    XcdBarrier b; b.bar = bar; b.x = xb_xcc_id(); b.st = st; b.wave = wave;
    if (wave == 0 && lane_id() == 0) (void)xb_add(&bar[XB_XCNT(b.x)], 1u);
    return b;
}
__device__ __forceinline__ void xcd_barrier_complete(unsigned* bar, unsigned x, unsigned& nloc, unsigned& nx) {
    const unsigned G = gridDim.x * gridDim.y * gridDim.z;
    unsigned sum, cnt, mine, sp = 0u;
    for (;;) {
        sum = 0u; cnt = 0u; mine = 0u;
#pragma unroll
        for (unsigned j = 0; j < 16; ++j) { const unsigned c = xb_ld(&bar[XB_XCNT(j)]); sum += c; cnt += (c > 0u) ? 1u : 0u; mine = (j == x) ? c : mine; }
        if (sum == G) break;
        __builtin_amdgcn_s_sleep(1);
        if ((++sp & 255u) == 0u) { if (xb_ld(&bar[XB_TMO])) break; if (sp > XB_SPIN_CAP) { atomicAdd(&bar[XB_TMO], 1u); break; } }
    }
    nloc = mine > 0u ? mine : 1u; nx = cnt > 0u ? cnt : 1u;
}

__device__ __forceinline__ void xcd_barrier(const XcdBarrier& b) {
    asm volatile("s_waitcnt vmcnt(0)" ::: "memory");
    __syncthreads();
    if (b.wave == 0 && lane_id() == 0) {
        unsigned* bar = b.bar;
        __builtin_amdgcn_s_waitcnt(0);
        unsigned nloc = b.st[0], nx = b.st[1];
        if (nloc == 0u) { xcd_barrier_complete(bar, b.x, nloc, nx); b.st[0] = nloc; b.st[1] = nx; }
        const unsigned old = xb_add(&bar[XB_XSUB(b.x)], 1u);
        const unsigned gen = old / nloc;
        if (old + 1u == (gen + 1u) * nloc) {
            __builtin_amdgcn_fence(__ATOMIC_RELEASE, "agent");
            asm volatile("s_waitcnt vmcnt(0)" ::: "memory");
            const unsigned og = xb_add(&bar[XB_TOP], 1u);
            const unsigned tg = og / nx;
            if (og + 1u == (tg + 1u) * nx) xb_add(&bar[XB_TOPGEN], 1u);
            else XB_SPIN(xb_ld(&bar[XB_TOPGEN]) == tg, bar);
            __builtin_amdgcn_fence(__ATOMIC_ACQUIRE, "agent");
            xb_add(&bar[XB_XGEN(b.x)], 1u);
            asm volatile("s_waitcnt vmcnt(0)" ::: "memory");
        } else {
            XB_SPIN(xb_ld(&bar[XB_XGEN(b.x)]) == gen, bar);
            __builtin_amdgcn_fence(__ATOMIC_ACQUIRE, "agent");
            asm volatile("s_waitcnt vmcnt(0)" ::: "memory");
        }
    }
    __syncthreads();
}

struct Args { const float* in[22]; float* out; unsigned char* ws; int ph_lo, ph_hi; };
struct Frame {
    LAS unsigned char* lds;
    volatile LAS unsigned* MISC;
    int wave, vcu, G;
};
enum { IN_X = 0, IN_C, IN_CTX, IN_CCTX, IN_ADAW, IN_ADAB, IN_NORMG, IN_MWIN, IN_MGB, IN_MHG, IN_MWOUT, IN_AWIN, IN_AWOUT, IN_AQG, IN_AKG, IN_LQ1, IN_LK1, IN_LQ2, IN_LK2, IN_SUBG, IN_WGU, IN_WDN };

__device__ __forceinline__ void p0_transpose_item(const float* W, int K, int N, bf16* WT, int mode, LAS float* scr, int item, int lane) {
    const int nblk = N / 32, kb = item / nblk, nb = item % nblk, k0 = 64 * kb, n0 = 32 * nb;
    int r0 = n0, rstep = 1;
    if (mode == 2 && n0 < 2 * DM) { const int head = n0 >> 7, d0 = n0 & 127; r0 = head * 128 + (d0 >> 6) * 64 + ((d0 >> 5) & 1); rstep = 2; }
    if (mode == 1) { const int up = n0 >= FFH ? 1 : 0, j = n0 - up * FFH; r0 = (j >> 7) * 256 + up * 128 + (j & 127); }
    { const int r8 = lane >> 3, c4 = lane & 7;
      f32x4 t[8];
#pragma unroll
      for (int i = 0; i < 8; ++i) t[i] = *(const GAS f32x4*)(W + (size_t)(k0 + 8 * i + r8) * N + n0 + 4 * c4);
#pragma unroll
      for (int i = 0; i < 8; ++i) { LAS float* d = scr + (8 * i + r8) * 33 + 4 * c4; d[0] = t[i].x; d[1] = t[i].y; d[2] = t[i].z; d[3] = t[i].w; } }
    LDS_WAIT(); asm volatile("" ::: "memory");
    const int c = lane & 7;
#pragma unroll
    for (int j = 0; j < 4; ++j) { const int n = (lane >> 3) + 8 * j; const LAS float* s = scr + (8 * c) * 33 + n;
        v4u o; o.x = pk2(s[0 * 33], s[1 * 33]); o.y = pk2(s[2 * 33], s[3 * 33]); o.z = pk2(s[4 * 33], s[5 * 33]); o.w = pk2(s[6 * 33], s[7 * 33]);
        *(GAS v4u*)(WT + (size_t)(r0 + n * rstep) * K + k0 + 8 * c) = o; }
    LDS_WAIT(); asm volatile("" ::: "memory");
}
constexpr int I_MIN = (DM / 64) * (MIN_REAL / 32), I_SQ = (DM / 64) * (DM / 32), I_AIN = (DM / 64) * (AIN / 32), I_GU = (DM / 64) * (NGU / 32), I_DN = (FFH / 64) * (DM / 32);
__device__ __forceinline__ int layer_items(int L) { return ((L & 1) ? I_AIN : I_MIN) + I_SQ + I_GU + I_DN; }
__device__ __forceinline__ void convert_item_layer(const Args& A, int L, int idx, LAS float* scr, int lane) {
    const bool ml = (L & 1) == 0; const int j = L >> 1, iin = ml ? I_MIN : I_AIN;
    if (idx < iin) { if (ml) p0_transpose_item(A.in[IN_MWIN] + (size_t)j * DM * MIN_REAL, DM, MIN_REAL, (bf16*)(A.ws + WS_W_MIN) + (size_t)j * MIN_PAD * DM, 0, scr, idx, lane);
                     else p0_transpose_item(A.in[IN_AWIN] + (size_t)j * DM * AIN, DM, AIN, (bf16*)(A.ws + WS_W_AIN) + (size_t)j * AIN * DM, 2, scr, idx, lane); return; }
    idx -= iin;
    if (idx < I_SQ) { p0_transpose_item((ml ? A.in[IN_MWOUT] : A.in[IN_AWOUT]) + (size_t)j * DM * DM, DM, DM, (bf16*)(A.ws + (ml ? WS_W_MOUT : WS_W_AOUT)) + (size_t)j * DM * DM, 0, scr, idx, lane); return; }
    idx -= I_SQ;
    if (idx < I_GU) { p0_transpose_item(A.in[IN_WGU] + (size_t)L * DM * NGU, DM, NGU, (bf16*)(A.ws + WS_W_GU) + (size_t)L * NGU * DM, 1, scr, idx, lane); return; }
    idx -= I_GU;
    p0_transpose_item(A.in[IN_WDN] + (size_t)L * FFH * DM, FFH, DM, (bf16*)(A.ws + WS_W_DN) + (size_t)L * DM * FFH, 0, scr, idx, lane);
}
__device__ __forceinline__ void help_convert(Frame& F, const Args& A, int L, int budget) {
    const int lane = lane_id();
    unsigned* qh = (unsigned*)(A.ws + WS_CTL) + CW_Q0 + 64 * L;
    const int nit = layer_items(L), nch = (nit + 15) >> 4;
    LAS float* scr = (LAS float*)(F.lds + F.wave * 16384);
    for (int k = 0; k < budget; ++k) {
        if (F.wave == 0 && lane == 0) F.MISC[16 + (k & 1)] = __hip_atomic_fetch_add(qh, 1u, __ATOMIC_RELAXED, __HIP_MEMORY_SCOPE_AGENT);
        __syncthreads();
        const int ch = (int)F.MISC[16 + (k & 1)];
        if (ch >= nch) break;
#pragma unroll
        for (int i = 0; i < 2; ++i) { const int it = ch * 16 + i * 8 + F.wave; if (it < nit) convert_item_layer(A, L, it, scr, lane); }
    }
}
__device__ __forceinline__ float silu_f(float x) { return x / (1.0f + __expf(-x)); }
__device__ __forceinline__ void p0_prologue(Frame& F, const Args& A_, int conv_layers) {
    const Args& A = A_;
    const int lane_l = lane_id(), tid_l = F.wave * 64 + lane_l; (void)tid_l; (void)lane_l;
    float* MOD = (float*)(A.ws + WS_MOD);
    if ((int)blockIdx.x < 192) {
        LAS float* sc = (LAS float*)F.lds;
        LAS float* part = (LAS float*)(F.lds + 40960);
        for (int i = tid_l; i < 5 * DM; i += NWAVES * 64) { const float v = i < 4 * DM ? A.in[IN_C][i] : A.in[IN_CCTX][i - 4 * DM]; sc[i] = silu_f(v); }
        __syncthreads();
        for (int it = blockIdx.x; it < 192; it += F.G) {
            const int l = it / 48, strip = it % 48;
            const float* W = A.in[IN_ADAW] + (size_t)l * DM * 12288 + strip * 256 + lane_l * 4;
            f32x4 acc[5];
#pragma unroll
            for (int r = 0; r < 5; ++r) acc[r] = (f32x4){0.f, 0.f, 0.f, 0.f};
            const int kbeg = F.wave * 256;
#pragma unroll 2
            for (int k = kbeg; k < kbeg + 256; k += 4) {
                const f32x4 w0 = *(const GAS f32x4*)(W + (size_t)(k + 0) * 12288), w1 = *(const GAS f32x4*)(W + (size_t)(k + 1) * 12288);
                const f32x4 w2 = *(const GAS f32x4*)(W + (size_t)(k + 2) * 12288), w3 = *(const GAS f32x4*)(W + (size_t)(k + 3) * 12288);
#pragma unroll
                for (int r = 0; r < 5; ++r) { const f32x4 s = *(const LAS f32x4*)(sc + r * DM + k); acc[r] += w0 * s.x + w1 * s.y + w2 * s.z + w3 * s.w; }
            }
#pragma unroll
            for (int r = 0; r < 5; ++r) *(LAS f32x4*)(part + ((F.wave * 5 + r) * 64 + lane_l) * 4) = acc[r];
            __syncthreads();
            for (int o = tid_l; o < 5 * 256; o += NWAVES * 64) { const int r = o >> 8, c = o & 255; float s = A.in[IN_ADAB][l * 12288 + strip * 256 + c];
#pragma unroll
                for (int w = 0; w < 8; ++w) s += part[(w * 5 + r) * 256 + c];
                MOD[(size_t)(l * 5 + r) * 12288 + strip * 256 + c] = s; }
            __syncthreads();
        }
    }
    __syncthreads();
    LAS float* scr = (LAS float*)(F.lds + F.wave * 16384);
    const int gw = F.vcu * NWAVES + F.wave, NGW = F.G * NWAVES;
    for (int L = 0; L < conv_layers; ++L) help_convert(F, A, L, 1 << 30);
}

template <bool FIRST>
__device__ __forceinline__ void norm_phase(Frame& F, const Args& A_, int layer, int which, int row_begin, int mrows, const float* slab_gate) {
    const Args& A = A_;
    const int lane_l = lane_id(), tid_l = F.wave * 64 + lane_l; (void)tid_l; (void)lane_l;
    const int gw = F.vcu * NWAVES + F.wave, NGW = F.G * NWAVES;
    unsigned short* X = (unsigned short*)(A.ws + WS_X); bf16* HN = (bf16*)(A.ws + WS_HN);
    const float* gain = A.in[IN_NORMG] + (size_t)(layer * 2 + which) * DM;
    const float* MODL = (const float*)(A.ws + WS_MOD) + (size_t)layer * 5 * 12288 + (which ? 3 * DM : 0);
    f32x4 GG[8], SH[8], vn[8]; int cur_m = -1;
#define VIDX(j_) (2 * lane_l + 128 * ((j_) >> 1) + ((j_) & 1))
#define NORM_LOAD(dst, r) do { if (FIRST) { const GAS f32x4* xr_ = (const GAS f32x4*)((r) < ML ? A.in[IN_X] + (size_t)(r) * DM : A.in[IN_CTX] + (size_t)((r) - ML) * DM); \
            _Pragma("unroll") for (int j_ = 0; j_ < 8; ++j_) dst[j_] = xr_[VIDX(j_)]; } \
        else { const GAS v4u* xr_ = (const GAS v4u*)(X + (size_t)(r) * DM) + lane_l; \
            _Pragma("unroll") for (int c_ = 0; c_ < 4; ++c_) { const v4u w_ = xr_[64 * c_]; dst[2 * c_] = (f32x4){h_lo(w_.x), h_hi(w_.x), h_lo(w_.y), h_hi(w_.y)}; dst[2 * c_ + 1] = (f32x4){h_lo(w_.z), h_hi(w_.z), h_lo(w_.w), h_hi(w_.w)}; } } } while (0)
#define NORM_STORE_X(r, src) do { GAS v4u* xo_ = (GAS v4u*)(X + (size_t)(r) * DM) + lane_l; \
        _Pragma("unroll") for (int c_ = 0; c_ < 4; ++c_) { v4u w_; w_.x = pkh2(src[2 * c_].x, src[2 * c_].y); w_.y = pkh2(src[2 * c_].z, src[2 * c_].w); w_.z = pkh2(src[2 * c_ + 1].x, src[2 * c_ + 1].y); w_.w = pkh2(src[2 * c_ + 1].z, src[2 * c_ + 1].w); xo_[64 * c_] = w_; } } while (0)
    int row = row_begin + gw;
    if (row < mrows) NORM_LOAD(vn, row);
    while (row < mrows) {
        f32x4 v[8]; float s = 0.f;
#pragma unroll
        for (int j = 0; j < 8; ++j) v[j] = vn[j];
        const int nrow = row + NGW;
        if (nrow < mrows) NORM_LOAD(vn, nrow);
        const int mrow = row < ML ? (row >> 12) : 4;
        if (mrow != cur_m) { cur_m = mrow; const float* md = MODL + (size_t)mrow * 12288;
#pragma unroll
            for (int j = 0; j < 8; ++j) { const f32x4 g = *((const GAS f32x4*)gain + VIDX(j)), sc = *((const GAS f32x4*)(md + DM) + VIDX(j));
                GG[j] = g * (sc + 1.0f); SH[j] = *((const GAS f32x4*)md + VIDX(j)); } }
        if (!FIRST && slab_gate != nullptr && row >= ML) {
            const GAS f32x4* sl = (const GAS f32x4*)((const float*)(A.ws + WS_SLAB) + (size_t)(row - ML) * DM);
#pragma unroll
            for (int j = 0; j < 8; ++j) { f32x4 p = sl[VIDX(j)];
#pragma unroll
                for (int k = 1; k < KSPLIT; ++k) p += sl[VIDX(j) + (size_t)k * MC * DM / 4];
                v[j] += *((const GAS f32x4*)slab_gate + VIDX(j)) * p; }
            NORM_STORE_X(row, v);
        }
#pragma unroll
        for (int j = 0; j < 8; ++j) s += (v[j].x * v[j].x + v[j].y * v[j].y) + (v[j].z * v[j].z + v[j].w * v[j].w);
        const float rs = 1.0f / sqrtf(wave_sum(s) * (1.0f / DM) + EPS);
        if (FIRST) NORM_STORE_X(row, v);
        GAS v4u* o16 = (GAS v4u*)(HN + (size_t)row * DM) + lane_l;
#pragma unroll
        for (int c = 0; c < 4; ++c) { const f32x4 y0 = (v[2 * c] * rs) * GG[2 * c] + SH[2 * c], y1 = (v[2 * c + 1] * rs) * GG[2 * c + 1] + SH[2 * c + 1];
            v4u w; w.x = pk2(y0.x, y0.y); w.y = pk2(y0.z, y0.w); w.z = pk2(y1.x, y1.y); w.w = pk2(y1.z, y1.w); o16[64 * c] = w; }
        row = nrow;
    }
#undef VIDX
#undef NORM_LOAD
#undef NORM_STORE_X
}

constexpr int SC_G = 0, SC_PM = 17408, SC_BC = 34816, SC_Q = 52224, SC_K = 69632, SC_V = 87040, SC_VW = 97280, SC_C = 107520, SC_SW = 129280, SC_END = 138496;
constexpr int QSTR = 272, VSTR = 160, SWSTR = 144, CTSTR = 272;
static_assert(SC_END <= RING_BYTES, "scan LDS map");
__device__ __forceinline__ int scan_row(int b, int dir, int c, int t) {
    if (c < 4) { const int p = c * 64 + t; return ML + b * CTXL + (dir ? (CTXL - 1 - p) : p); }
    const int p = (c - 4) * 64 + t; return b * SEQ + (dir ? (SEQ - 1 - p) : p);
}
__device__ __forceinline__ bf16x8 tr_pair(const LAS unsigned char* p, int stride4) {
    const s16x4 a = __builtin_amdgcn_ds_read_tr16_b64_v4i16((LAS s16x4*)p), b = __builtin_amdgcn_ds_read_tr16_b64_v4i16((LAS s16x4*)(p + stride4));
    return (bf16x8){a[0], a[1], a[2], a[3], b[0], b[1], b[2], b[3]};
}
#define LDS_BARRIER() do { asm volatile("s_waitcnt lgkmcnt(0)" ::: "memory"); __builtin_amdgcn_s_barrier(); asm volatile("" ::: "memory"); } while (0)
__device__ __forceinline__ void mlstm_scan_phase(Frame& F, const Args& A_) {
    const Args& A = A_;
    const bf16* PROJ = (const bf16*)(A.ws + WS_PROJ); const float* GATES = (const float*)(A.ws + WS_GATES);
    LAS unsigned char* lds = F.lds;
    LAS float* Gs = (LAS float*)(lds + SC_G); LAS float* PMs = (LAS float*)(lds + SC_PM); LAS float* BCs = (LAS float*)(lds + SC_BC);
    const int lane = lane_id(), wave = F.wave, tid = wave * 64 + lane, l15 = lane & 15, g4 = lane >> 4, tq = (lane >> 2) & 3, tp = lane & 3;
    const int sr = tid >> 3, sp = tid & 7;
    for (int u = blockIdx.x; u < 256; u += F.G) {
        const int b = u >> 6, h = (u >> 3) & 7, dir = (u >> 2) & 1, js = u & 3;
        _Float16* HO = (_Float16*)(A.ws + (dir ? WS_HB : WS_HF));
        for (int c = wave; c < 68; c += 8) {
            const int row = scan_row(b, dir, c, lane);
            const float iv = GATES[(size_t)row * 32 + dir * 16 + h], lf = GATES[(size_t)row * 32 + dir * 16 + 8 + h];
            float bs = lf;
#pragma unroll
            for (int d = 1; d < 64; d <<= 1) { const float t = __shfl_up(bs, d); if (lane >= d) bs += t; }
            const float g = iv - bs; float pm = g;
#pragma unroll
            for (int d = 1; d < 64; d <<= 1) { const float t = __shfl_up(pm, d); if (lane >= d) pm = fmaxf(pm, t); }
            Gs[c * 64 + lane] = g; PMs[c * 64 + lane] = pm; BCs[c * 64 + lane] = bs;
        }
        for (int i = tid; i < (80 * CTSTR) / 16; i += NWAVES * 64) *(LAS v4u*)(lds + SC_C + i * 16) = (v4u){0u, 0u, 0u, 0u};
        if (sp == 0) *(LAS v4u*)(lds + SC_V + sr * VSTR + 128) = (v4u){0x3F80u, 0u, 0u, 0u};
        if (sp == 1) { *(LAS v4u*)(lds + SC_V + sr * VSTR + 144) = (v4u){0u, 0u, 0u, 0u}; *(LAS v4u*)(lds + SC_VW + sr * VSTR + 144) = (v4u){0u, 0u, 0u, 0u}; }
        f32x4 Cacc[5];
#pragma unroll
        for (int e = 0; e < 5; ++e) Cacc[e] = (f32x4){0.f, 0.f, 0.f, 0.f};
        float m = 0.f;
        bf16x8 rq0, rq1, rk0, rk1, rv;
#define SCAN_LOAD(cc) do { const bf16* pr = PROJ + (size_t)scan_row(b, dir, (cc), sr) * LDP; \
            rq0 = *(const GAS bf16x8*)(pr + h * 128 + sp * 16); rq1 = *(const GAS bf16x8*)(pr + h * 128 + sp * 16 + 8); \
            rk0 = *(const GAS bf16x8*)(pr + 1024 + h * 128 + sp * 16); rk1 = *(const GAS bf16x8*)(pr + 1024 + h * 128 + sp * 16 + 8); \
            rv = *(const GAS bf16x8*)(pr + 2048 + h * 256 + js * 64 + sp * 8); } while (0)
        SCAN_LOAD(0);
        __syncthreads();
        float hv[8];
#pragma unroll
        for (int i = 0; i < 8; ++i) hv[i] = 0.f;
#define SCAN_STORE_H(cc) do { _Pragma("unroll") for (int r_ = 0; r_ < 4; ++r_) { _Float16* hp_ = HO + (size_t)scan_row(b, dir, (cc), 16 * (wave & 3) + 4 * g4 + r_) * DM + h * 256 + js * 64 + l15; \
            hp_[16 * (2 * (wave >> 2))] = (_Float16)__builtin_amdgcn_fmed3f(hv[2 * r_], -65000.0f, 65000.0f); hp_[16 * (2 * (wave >> 2) + 1)] = (_Float16)__builtin_amdgcn_fmed3f(hv[2 * r_ + 1], -65000.0f, 65000.0f); } } while (0)
        for (int c = 0; c < 68; ++c) {
            *(LAS bf16x8*)(lds + SC_Q + sr * QSTR + sp * 32) = rq0; *(LAS bf16x8*)(lds + SC_Q + sr * QSTR + sp * 32 + 16) = rq1;
            *(LAS bf16x8*)(lds + SC_K + sr * QSTR + sp * 32) = rk0; *(LAS bf16x8*)(lds + SC_K + sr * QSTR + sp * 32 + 16) = rk1;
            *(LAS bf16x8*)(lds + SC_V + sr * VSTR + sp * 16) = rv;
            { const float w63 = __expf(Gs[c * 64 + sr] - PMs[c * 64 + 63]);
              const v4u vr = __builtin_bit_cast(v4u, rv); v4u vw;
              vw.x = pk2(bf_lo(vr.x) * w63, bf_hi(vr.x) * w63); vw.y = pk2(bf_lo(vr.y) * w63, bf_hi(vr.y) * w63);
              vw.z = pk2(bf_lo(vr.z) * w63, bf_hi(vr.z) * w63); vw.w = pk2(bf_lo(vr.w) * w63, bf_hi(vr.w) * w63);
              *(LAS v4u*)(lds + SC_VW + sr * VSTR + sp * 16) = vw;
              if (sp == 0) *(LAS v4u*)(lds + SC_VW + sr * VSTR + 128) = (v4u){f2bf(w63), 0u, 0u, 0u}; }
            LDS_BARRIER();
            if (c > 0) SCAN_STORE_H(c - 1);
            if (c + 1 < 68) SCAN_LOAD(c + 1);
            const int tt = wave & 3, ch = wave >> 2;
            bf16x8 aq[4], bk[2][4], bc[3][4];
#pragma unroll
            for (int ks = 0; ks < 4; ++ks) aq[ks] = *(const LAS bf16x8*)(lds + SC_Q + (16 * tt + l15) * QSTR + ks * 64 + g4 * 16);
#pragma unroll
            for (int i = 0; i < 2; ++i)
#pragma unroll
                for (int ks = 0; ks < 4; ++ks) bk[i][ks] = *(const LAS bf16x8*)(lds + SC_K + (16 * (2 * ch + i) + l15) * QSTR + ks * 64 + g4 * 16);
#pragma unroll
            for (int i = 0; i < 3; ++i) { const int et = i < 2 ? 2 * ch + i : 4;
#pragma unroll
                for (int ks = 0; ks < 4; ++ks) bc[i][ks] = *(const LAS bf16x8*)(lds + SC_C + (16 * et + l15) * CTSTR + ks * 64 + g4 * 16); }
            float gsv[2], pmv[4];
#pragma unroll
            for (int i = 0; i < 2; ++i) gsv[i] = Gs[c * 64 + 16 * (2 * ch + i) + l15];
#pragma unroll
            for (int r = 0; r < 4; ++r) pmv[r] = PMs[c * 64 + 16 * tt + 4 * g4 + r];
            f32x4 sacc[2], cacc[3];
#pragma unroll
            for (int i = 0; i < 2; ++i) { sacc[i] = (f32x4){0.f, 0.f, 0.f, 0.f};
#pragma unroll
                for (int ks = 0; ks < 4; ++ks) sacc[i] = __builtin_amdgcn_mfma_f32_16x16x32_bf16(aq[ks], bk[i][ks], sacc[i], 0, 0, 0); }
#pragma unroll
            for (int i = 0; i < 3; ++i) { cacc[i] = (f32x4){0.f, 0.f, 0.f, 0.f};
#pragma unroll
                for (int ks = 0; ks < 4; ++ks) cacc[i] = __builtin_amdgcn_mfma_f32_16x16x32_bf16(aq[ks], bc[i][ks], cacc[i], 0, 0, 0); }
#pragma unroll
            for (int i = 0; i < 2; ++i) { const int s = 16 * (2 * ch + i) + l15; float sw[4];
#pragma unroll
                for (int r = 0; r < 4; ++r) { const int t = 16 * tt + 4 * g4 + r; const float e = __expf(fminf(gsv[i] - pmv[r], 0.f)), mk = (s <= t) ? 1.0f : 0.0f; sw[r] = sacc[i][r] * e * mk; }
                v2u pk; pk.x = pk2(sw[0], sw[1]); pk.y = pk2(sw[2], sw[3]);
                *(LAS v2u*)(lds + SC_SW + s * SWSTR + (16 * tt + 4 * g4) * 2) = pk; }
            LDS_BARRIER();
            bf16x8 as2[2], bv[3][2], ak[2], bw[5][2];
#pragma unroll
            for (int k2 = 0; k2 < 2; ++k2) as2[k2] = tr_pair(lds + SC_SW + (32 * k2 + 8 * g4 + tq) * SWSTR + (16 * tt + 4 * tp) * 2, 4 * SWSTR);
#pragma unroll
            for (int i = 0; i < 3; ++i) { const int et = i < 2 ? 2 * ch + i : 4;
#pragma unroll
                for (int k2 = 0; k2 < 2; ++k2) bv[i][k2] = tr_pair(lds + SC_V + (32 * k2 + 8 * g4 + tq) * VSTR + (16 * et + 4 * tp) * 2, 4 * VSTR); }
#pragma unroll
            for (int k2 = 0; k2 < 2; ++k2) ak[k2] = tr_pair(lds + SC_K + (32 * k2 + 8 * g4 + tq) * QSTR + (16 * wave + 4 * tp) * 2, 4 * QSTR);
#pragma unroll
            for (int et = 0; et < 5; ++et)
#pragma unroll
                for (int k2 = 0; k2 < 2; ++k2) bw[et][k2] = tr_pair(lds + SC_VW + (32 * k2 + 8 * g4 + tq) * VSTR + (16 * et + 4 * tp) * 2, 4 * VSTR);
            float bcv[4]; const float pm63 = PMs[c * 64 + 63], b63 = BCs[c * 64 + 63];
#pragma unroll
            for (int r = 0; r < 4; ++r) bcv[r] = BCs[c * 64 + 16 * tt + 4 * g4 + r];
            f32x4 nacc[3], dC[5];
#pragma unroll
            for (int i = 0; i < 3; ++i) { nacc[i] = (f32x4){0.f, 0.f, 0.f, 0.f};
#pragma unroll
                for (int k2 = 0; k2 < 2; ++k2) nacc[i] = __builtin_amdgcn_mfma_f32_16x16x32_bf16(as2[k2], bv[i][k2], nacc[i], 0, 0, 0); }
#pragma unroll
            for (int et = 0; et < 5; ++et) { dC[et] = (f32x4){0.f, 0.f, 0.f, 0.f};
#pragma unroll
                for (int k2 = 0; k2 < 2; ++k2) dC[et] = __builtin_amdgcn_mfma_f32_16x16x32_bf16(ak[k2], bw[et][k2], dC[et], 0, 0, 0); }
            float inv[4];
#pragma unroll
            for (int r = 0; r < 4; ++r) { const float pm = pmv[r], Mt = fmaxf(m, pm), wi = __expf(m - Mt), wl = __expf(pm - Mt);
#pragma unroll
                for (int i = 0; i < 3; ++i) nacc[i][r] = wi * cacc[i][r] + wl * nacc[i][r];
                const float den = __shfl(nacc[2][r], lane & 48);
                inv[r] = __builtin_amdgcn_rcpf(fmaxf(fabsf(den), __expf(-(bcv[r] + Mt)))); }
#pragma unroll
            for (int r = 0; r < 4; ++r) { hv[2 * r] = nacc[0][r] * inv[r]; hv[2 * r + 1] = nacc[1][r] * inv[r]; }
            { const float M63 = fmaxf(m, pm63), dec = __expf(m - M63), scal = __expf(pm63 - M63);
#pragma unroll
              for (int et = 0; et < 5; ++et) { Cacc[et] = Cacc[et] * dec + dC[et] * scal;
                  v2u pk; pk.x = pk2(Cacc[et][0], Cacc[et][1]); pk.y = pk2(Cacc[et][2], Cacc[et][3]);
                  *(LAS v2u*)(lds + SC_C + (16 * et + l15) * CTSTR + (16 * wave + 4 * g4) * 2) = pk; }
              m = b63 + M63; }
            LDS_BARRIER();
        }
        SCAN_STORE_H(67);
#undef SCAN_LOAD
#undef SCAN_STORE_H
    }
}
__device__ __forceinline__ void mlstm_finish_phase(Frame& F, const Args& A_, int j) {
    const Args& A = A_;
    const int lane_l = lane_id(), tid_l = F.wave * 64 + lane_l; (void)tid_l; (void)lane_l;
    const int gw = F.vcu * NWAVES + F.wave, NGW = F.G * NWAVES;
    const unsigned short* HF = (const unsigned short*)(A.ws + WS_HF); const unsigned short* HB = (const unsigned short*)(A.ws + WS_HB);
    const bf16* PROJ = (const bf16*)(A.ws + WS_PROJ); bf16* OB = (bf16*)(A.ws + WS_OB);
    const float* hg = A.in[IN_MHG] + (size_t)j * DM;
    for (int row = gw; row < MT; row += NGW) {
        const GAS v4u* a = (const GAS v4u*)(HF + (size_t)row * DM) + lane_l; const GAS v4u* bq = (const GAS v4u*)(HB + (size_t)row * DM) + lane_l;
        const GAS v4u* og = (const GAS v4u*)(PROJ + (size_t)row * LDP + 4096) + lane_l;
        GAS v4u* o16 = (GAS v4u*)(OB + (size_t)row * DM) + lane_l;
#pragma unroll
        for (int st = 0; st < 4; ++st) {
            const v4u wa = a[64 * st], wb = bq[64 * st], ow = og[64 * st];
            float v[8] = {h_lo(wa.x) + h_lo(wb.x), h_hi(wa.x) + h_hi(wb.x), h_lo(wa.y) + h_lo(wb.y), h_hi(wa.y) + h_hi(wb.y), h_lo(wa.z) + h_lo(wb.z), h_hi(wa.z) + h_hi(wb.z), h_lo(wa.w) + h_lo(wb.w), h_hi(wa.w) + h_hi(wb.w)};
            float ss = 0.f;
#pragma unroll
            for (int i = 0; i < 8; ++i) ss += v[i] * v[i];
            ss += __shfl_xor(ss, 1); ss += __shfl_xor(ss, 2); ss += __shfl_xor(ss, 4); ss += __shfl_xor(ss, 8); ss += __shfl_xor(ss, 16);
            const float rs = 1.0f / sqrtf(ss * (1.0f / DVH) + EPS);
            const f32x4 g0 = *((const GAS f32x4*)hg + 2 * lane_l + 128 * st), g1 = *((const GAS f32x4*)hg + 2 * lane_l + 128 * st + 1);
            const float o[8] = {bf_lo(ow.x), bf_hi(ow.x), bf_lo(ow.y), bf_hi(ow.y), bf_lo(ow.z), bf_hi(ow.z), bf_lo(ow.w), bf_hi(ow.w)};
            float y[8];
#pragma unroll
            for (int i = 0; i < 8; ++i) y[i] = v[i] * rs * (i < 4 ? g0[i] : g1[i - 4]) * (1.0f / (1.0f + __expf(-o[i])));
            v4u w; w.x = pk2(y[0], y[1]); w.y = pk2(y[2], y[3]); w.z = pk2(y[4], y[5]); w.w = pk2(y[6], y[7]); o16[64 * st] = w;
        }
    }
}

constexpr float QSCALE = 0.08838834764831845f * 1.4426950408889634f;
__device__ __forceinline__ void qknorm_phase(Frame& F, const Args& A_, int j) {
    const Args& A = A_;
    const int lane_l = lane_id(), tid_l = F.wave * 64 + lane_l; (void)tid_l; (void)lane_l;
    const int gw = F.vcu * NWAVES + F.wave, NGW = F.G * NWAVES;
    bf16* PROJ = (bf16*)(A.ws + WS_PROJ);
    const float* qg = A.in[IN_AQG] + (size_t)j * 128; const float* kg = A.in[IN_AKG] + (size_t)j * 128;
    const int fgrp = lane_l & 7, half = (lane_l >> 3) & 1, hvsub = lane_l >> 4;
    float fr[4];
#pragma unroll
    for (int i = 0; i < 4; ++i) fr[i] = exp2f(-(float)(4 * fgrp + i) * (13.287712379549449f / 32.0f)) * 0.15915494309189535f;
    f32x4 gq1 = *(const f32x4*)(qg + half * 64 + 4 * fgrp), gq2 = *(const f32x4*)(qg + half * 64 + 32 + 4 * fgrp);
    f32x4 gk1 = *(const f32x4*)(kg + half * 64 + 4 * fgrp), gk2 = *(const f32x4*)(kg + half * 64 + 32 + 4 * fgrp);
    for (int row = gw; row < MT; row += NGW) {
        float cs[4], sn[4];
        if (row < ML) { const int s = row & (SEQ - 1); const float pos = (float)(half ? (s & 63) : (s >> 6));
#pragma unroll
            for (int i = 0; i < 4; ++i) { float rev = pos * fr[i]; rev -= rintf(rev); cs[i] = __builtin_amdgcn_cosf(rev); sn[i] = __builtin_amdgcn_sinf(rev); }
        } else {
#pragma unroll
            for (int i = 0; i < 4; ++i) { cs[i] = 1.f; sn[i] = 0.f; } }
        bf16* base = PROJ + (size_t)row * LDP + half * 64 + 4 * fgrp;
#pragma unroll
        for (int it = 0; it < 8; ++it) {
            const int hv = 4 * it + hvsub;
            GAS v2u* p1 = (GAS v2u*)(base + hv * 128); GAS v2u* p2 = (GAS v2u*)(base + hv * 128 + 32);
            const v2u a = *p1, c = *p2;
            float x1[4] = {bf_lo(a.x), bf_hi(a.x), bf_lo(a.y), bf_hi(a.y)}, x2[4] = {bf_lo(c.x), bf_hi(c.x), bf_lo(c.y), bf_hi(c.y)};
            float ss = 0.f;
#pragma unroll
            for (int i = 0; i < 4; ++i) ss += x1[i] * x1[i] + x2[i] * x2[i];
            ss += __shfl_xor(ss, 1); ss += __shfl_xor(ss, 2); ss += __shfl_xor(ss, 4); ss += __shfl_xor(ss, 8);
            const bool isq = hv < 16;
            const float rs = (1.0f / sqrtf(ss * (1.0f / 128.0f) + EPS)) * (isq ? QSCALE : 1.0f);
            const f32x4 g1 = isq ? gq1 : gk1, g2 = isq ? gq2 : gk2;
            float o1[4], o2[4];
#pragma unroll
            for (int i = 0; i < 4; ++i) { const float y1 = x1[i] * rs * g1[i], y2 = x2[i] * rs * g2[i]; o1[i] = y1 * cs[i] - y2 * sn[i]; o2[i] = y2 * cs[i] + y1 * sn[i]; }
            v2u w1, w2; w1.x = pk2(o1[0], o1[1]); w1.y = pk2(o1[2], o1[3]); w2.x = pk2(o2[0], o2[1]); w2.y = pk2(o2[2], o2[3]);
            *p1 = w1; *p2 = w2;
        }
    }
}
constexpr int AT_K = 0, AT_V = 65536, AT_SCR = 131072, AT_PAR = AT_SCR + 2048;
#define KSWZ(row, colB) ((row) * 256 + ((colB) ^ (((row) & 7) << 4)))
__device__ __forceinline__ int crow(int r, int hi) { return (r & 3) + 8 * (r >> 2) + 4 * hi; }
__device__ __forceinline__ int v_st8(int k, int c) { const int kk = (k & ~0xC) | ((k & 4) << 1) | ((k & 8) >> 1); return ((kk >> 3) * 8 + (c >> 5)) * 512 + ((kk & 7) * 32 + (c & 31)) * 2; }
__device__ __forceinline__ int v_rd_base(int lane) { return ((lane & 3) << 3) | (((lane >> 2) & 3) << 6) | (((lane >> 4) & 1) << 5) | (((lane >> 5) & 1) << 8); }
template <int D0> __device__ __forceinline__ void pv_one(f32x16& od, const LAS unsigned char* vb, bf16x8 pa0, bf16x8 pa1, bf16x8 pa2, bf16x8 pa3) {
#define TRR(ks, half) __builtin_amdgcn_ds_read_tr16_b64_v4i16((LAS s16x4*)(vb + D0 * 512 + (ks) * 8192 + (half) * 4096))
    const s16x4 l0 = TRR(0, 0), h0 = TRR(0, 1), l1 = TRR(1, 0), h1 = TRR(1, 1), l2 = TRR(2, 0), h2 = TRR(2, 1), l3 = TRR(3, 0), h3 = TRR(3, 1);
#undef TRR
#define PK(L, H) (bf16x8){L[0], L[1], L[2], L[3], H[0], H[1], H[2], H[3]}
    od = __builtin_amdgcn_mfma_f32_32x32x16_bf16(pa0, PK(l0, h0), od, 0, 0, 0);
    od = __builtin_amdgcn_mfma_f32_32x32x16_bf16(pa1, PK(l1, h1), od, 0, 0, 0);
    od = __builtin_amdgcn_mfma_f32_32x32x16_bf16(pa2, PK(l2, h2), od, 0, 0, 0);
    od = __builtin_amdgcn_mfma_f32_32x32x16_bf16(pa3, PK(l3, h3), od, 0, 0, 0);
#undef PK
}
__device__ __forceinline__ void glds16_asm(const void* gsrc, unsigned lds_dst) {
    unsigned keep;
    asm volatile("s_mov_b32 %0, m0\n\ts_mov_b32 m0, %2\n\ts_nop 0\n\tglobal_load_lds_dwordx4 %1, off\n\ts_mov_b32 m0, %0" : "=&s"(keep) : "v"(gsrc), "s"(lds_dst) : "memory");
}
__device__ __forceinline__ unsigned cvtpk(float lo, float hi) { return cvt_pk_bf16_hw(lo, hi); }
__device__ __forceinline__ void attn_phase(Frame& F, const Args& A_, int layer, int j, bool upd) {
    const Args& A = A_;
    LAS unsigned char* lds = F.lds;
    const bf16* PROJ = (const bf16*)(A.ws + WS_PROJ); bf16* OB = (bf16*)(A.ws + WS_OB);
    const int lane = lane_id(), wave = F.wave, tid = wave * 64 + lane, r32 = lane & 31, hi = lane >> 5, g = wave & 3, mp = wave >> 2;
    LAS float* par = (LAS float*)(lds + AT_PAR);
    if (wave == 0) {
        const float* lq1 = A.in[IN_LQ1] + j * 128; const float* lk1 = A.in[IN_LK1] + j * 128; const float* lq2 = A.in[IN_LQ2] + j * 128; const float* lk2 = A.in[IN_LK2] + j * 128;
        const float s1 = wave_sum(lq1[lane] * lk1[lane] + lq1[lane + 64] * lk1[lane + 64]), s2 = wave_sum(lq2[lane] * lk2[lane] + lq2[lane + 64] * lk2[lane + 64]);
        float qm = fmaxf(fabsf(A.in[IN_AQG][j * 128 + lane]), fabsf(A.in[IN_AQG][j * 128 + lane + 64])), km = fmaxf(fabsf(A.in[IN_AKG][j * 128 + lane]), fabsf(A.in[IN_AKG][j * 128 + lane + 64]));
#pragma unroll
        for (int o = 1; o < 64; o <<= 1) { qm = fmaxf(qm, __shfl_xor(qm, o)); km = fmaxf(km, __shfl_xor(km, o)); }
        if (lane == 0) { par[0] = expf(s1) - expf(s2) + (0.8f - 0.6f * expf(-0.3f * (float)layer)); par[1] = 128.0f * qm * km * QSCALE * 1.02f; }
    }
    __syncthreads();
    const float lam = par[0], Mb = par[1], lam_init = 0.8f - 0.6f * expf(-0.3f * (float)layer);
    const float* subg = A.in[IN_SUBG] + (size_t)j * 256;
    const int nunits = upd ? 1088 : 1024;
    unsigned off0, off1;
    if (wave < 4) { const int ra = lane >> 4, rb = 4 + (lane >> 4); off0 = (unsigned)(ra * LDP + (((lane & 15) ^ ra) * 8)) * 2u; off1 = (unsigned)(rb * LDP + (((lane & 15) ^ rb) * 8)) * 2u; }
    else { const int rr = (lane & 31) >> 2; off0 = (unsigned)(((rr & 3) + 8 * (rr >> 2)) * LDP + 32 * (lane >> 5) + 8 * (lane & 3)) * 2u; off1 = off0; }
    const int dma_lds = (wave < 4) ? (AT_K + (wave >> 1) * 16384 + (wave & 1) * 8192) : (AT_V + (wave - 4) * 8192);
    LAS float* li_l = (LAS float*)(lds + AT_SCR) + wave * 64;
    for (int it = 0;; ++it) {
        const int L = it * F.G + (int)blockIdx.x;
        if (L >= nunits) break;
        int uid = L;
        if (F.G == 256 && L < 1024) uid = (it * 8 + ((int)blockIdx.x & 7)) * 32 + ((int)blockIdx.x >> 3);
        const bool isctx = uid >= 1024;
        int b, h, qrow0, nt;
        if (!isctx) { const int bh = uid >> 5; b = bh >> 3; h = bh & 7; qrow0 = b * SEQ + (uid & 31) * 128; nt = 68; }
        else { const int v = uid - 1024, bh = v >> 1; b = bh >> 3; h = bh & 7; qrow0 = ML + b * CTXL + (v & 1) * 128; nt = 4; }
#define KEYROW(jt) (isctx ? (ML + b * CTXL + (jt) * 64) : ((jt) < 64 ? (b * SEQ + (jt) * 64) : (ML + b * CTXL + ((jt) - 64) * 64)))
        bf16x8 qr[8];
        { const bf16* qp = PROJ + (size_t)(qrow0 + 32 * g + r32) * LDP + (2 * h + mp) * 128 + hi * 8;
#pragma unroll
          for (int d0 = 0; d0 < 8; ++d0) qr[d0] = *(const GAS bf16x8*)(qp + d0 * 16); }
        f32x16 o[8];
#pragma unroll
        for (int d0 = 0; d0 < 8; ++d0) o[d0] = (f32x16){};
        float l_reg = 0.f;
        const int hoff = (wave < 4) ? (2048 + (2 * h + (wave >> 1)) * 128) : (4096 + h * 256);
#define DMA_TILE(jt, bf) do { const char* tp_ = (const char*)(PROJ + (size_t)KEYROW(jt) * LDP + hoff); \
            _Pragma("unroll") for (int n_ = 0; n_ < 8; ++n_) { const int ub_ = (wave < 4) ? (32 * (wave & 1) + 8 * (n_ >> 1)) * LDP * 2 : ((4 * (n_ >> 2) + 16 * (wave - 4)) * LDP + 64 * (n_ & 3)) * 2; \
                __builtin_amdgcn_global_load_lds((const unsigned*)(tp_ + ub_ + ((n_ & 1) ? off1 : off0)), (LAS unsigned*)(lds + dma_lds + (bf) * 32768 + n_ * 1024), 16, 0, 0); } } while (0)
        DMA_TILE(0, 0);
        VM_WAIT();
        __syncthreads();
        for (int jt = 0; jt < nt; ++jt) {
            const int bf = jt & 1; const bool more = jt + 1 < nt;
            if (more) DMA_TILE(jt + 1, bf ^ 1);
            const LAS unsigned char* Ks = lds + AT_K + bf * 32768 + mp * 16384;
            bf16x8 pa0, pa1, pa2, pa3; float ps = 0.f;
#define PK4(P, BASE, OUT) do { unsigned a0 = cvtpk(P[BASE + 0], P[BASE + 1]), a1 = cvtpk(P[BASE + 2], P[BASE + 3]); \
    unsigned b0 = cvtpk(P[BASE + 4], P[BASE + 5]), b1 = cvtpk(P[BASE + 6], P[BASE + 7]); \
    auto r0 = __builtin_amdgcn_permlane32_swap(a0, b0, false, false); auto r1 = __builtin_amdgcn_permlane32_swap(a1, b1, false, false); \
    v4u w = {r0[0], r1[0], r0[1], r1[1]}; OUT = __builtin_bit_cast(bf16x8, w); } while (0)
            { f32x16 p;
#pragma unroll
              for (int r = 0; r < 16; ++r) p[r] = -Mb;
#pragma unroll
              for (int d0 = 0; d0 < 8; ++d0) { const bf16x8 b0 = *(const LAS bf16x8*)(Ks + KSWZ(r32, (d0 * 16 + hi * 8) * 2)); p = __builtin_amdgcn_mfma_f32_32x32x16_bf16(b0, qr[d0], p, 0, 0, 0); }
#pragma unroll
              for (int r = 0; r < 16; ++r) { p[r] = __builtin_amdgcn_exp2f(p[r]); ps += p[r]; }
              PK4(p, 0, pa0); PK4(p, 8, pa1); }
            __builtin_amdgcn_sched_barrier(0);
            { f32x16 p;
#pragma unroll
              for (int r = 0; r < 16; ++r) p[r] = -Mb;
#pragma unroll
              for (int d0 = 0; d0 < 8; ++d0) { const bf16x8 b1 = *(const LAS bf16x8*)(Ks + KSWZ(32 + r32, (d0 * 16 + hi * 8) * 2)); p = __builtin_amdgcn_mfma_f32_32x32x16_bf16(b1, qr[d0], p, 0, 0, 0); }
#pragma unroll
              for (int r = 0; r < 16; ++r) { p[r] = __builtin_amdgcn_exp2f(p[r]); ps += p[r]; }
              PK4(p, 0, pa2); PK4(p, 8, pa3); }
#undef PK4
            { auto rr = __builtin_amdgcn_permlane32_swap(__float_as_uint(ps), __float_as_uint(ps), false, false); ps = __uint_as_float(rr[0]) + __uint_as_float(rr[1]); }
            l_reg += ps;
            { const LAS unsigned char* vb = lds + AT_V + bf * 32768 + v_rd_base(lane);
              pv_one<0>(o[0], vb, pa0, pa1, pa2, pa3); pv_one<1>(o[1], vb, pa0, pa1, pa2, pa3); pv_one<2>(o[2], vb, pa0, pa1, pa2, pa3); pv_one<3>(o[3], vb, pa0, pa1, pa2, pa3);
              pv_one<4>(o[4], vb, pa0, pa1, pa2, pa3); pv_one<5>(o[5], vb, pa0, pa1, pa2, pa3); pv_one<6>(o[6], vb, pa0, pa1, pa2, pa3); pv_one<7>(o[7], vb, pa0, pa1, pa2, pa3); }
            VM_WAIT();
            __syncthreads();
        }
#undef DMA_TILE
#undef KEYROW
        const int lane_e = lane_id(), r32e = lane_e & 31, hie = lane_e >> 5;
        if (hie == 0) li_l[r32e] = l_reg;
        LDS_WAIT();
        float rli[16];
#pragma unroll
        for (int r = 0; r < 16; ++r) rli[r] = __builtin_amdgcn_rcpf(li_l[crow(r, hie)]);
        LAS float* ex = (LAS float*)lds + (size_t)g * 128 * 64 + lane_e;
        if (mp == 1) {
#pragma unroll
            for (int d0 = 0; d0 < 8; ++d0)
#pragma unroll
                for (int r = 0; r < 16; ++r) ex[(d0 * 16 + r) * 64] = o[d0][r] * rli[r] * lam;
        }
        __syncthreads();
        if (mp == 0) {
            float ssq[16];
#pragma unroll
            for (int r = 0; r < 16; ++r) ssq[r] = 0.f;
#pragma unroll
            for (int d0 = 0; d0 < 8; ++d0)
#pragma unroll
                for (int r = 0; r < 16; ++r) { const float v = o[d0][r] * rli[r] - ex[(d0 * 16 + r) * 64]; o[d0][r] = v; ssq[r] += v * v; }
#pragma unroll
            for (int r = 0; r < 16; ++r) { float s = ssq[r]; s += __shfl_xor(s, 1); s += __shfl_xor(s, 2); s += __shfl_xor(s, 4); s += __shfl_xor(s, 8); s += __shfl_xor(s, 16);
                ssq[r] = (1.0f / sqrtf(s * (1.0f / 256.0f) + EPS)) * (1.0f - lam_init); }
#pragma unroll
            for (int d0 = 0; d0 < 8; ++d0) { const float gs = subg[32 * d0 + r32e];
#pragma unroll
                for (int r = 0; r < 16; ++r) OB[(size_t)(qrow0 + 32 * g + crow(r, hie)) * DM + h * 256 + 32 * d0 + r32e] = (bf16)f2bf(o[d0][r] * ssq[r] * gs); }
        }
        __syncthreads();
    }
}

#ifndef MK_N_LAUNCHES
#define MK_N_LAUNCHES 1
#endif
#ifndef DBG_BAR2
#define DBG_BAR2 0
#endif
#ifndef DBG_REP
#define DBG_REP 0
#endif
#define REPS(kind) (((DBG_REP) & (kind)) ? 2 : 1)
#ifndef HELP_BUDGET
#define HELP_BUDGET 3
#endif
enum { PH_P0 = 1, PH_NORM1 = 2, PH_INPROJ = 4, PH_SCAN = 8, PH_FINISH = 16, PH_QKNORM = 32, PH_ATTN = 64, PH_OUTPROJ = 128, PH_NORM2 = 256, PH_GU = 512, PH_DOWN = 1024, PH_ALL = 2047 };
template <int MASK, bool SEAMS, int LAYER>
__device__ __forceinline__ void run_layer(Frame& F, const Args& A_, const XcdBarrier& bar, int lrt) {
#define LAUNDER_ARGS() const Args& A = A_
#define SEAM() do { if constexpr (SEAMS) { xcd_barrier(bar); if (DBG_BAR2) xcd_barrier(bar); } } while (0)
    {
        const int layer = (LAYER >= 0) ? LAYER : lrt;
        const int j = layer >> 1; const bool last = (layer == LASTL); const bool upd = !last && layer < CTXUPD; const int mrows = upd ? MT : ML;
        if constexpr ((MASK & PH_NORM1) != 0) { if (layer == 0) norm_phase<true>(F, A_, 0, 0, 0, MT, nullptr); else norm_phase<false>(F, A_, layer, 0, ML, MT, (layer - 1 < CTXUPD) ? (const float*)(A_.ws + WS_MOD) + (size_t)((layer - 1) * 5 + 4) * 12288 + 5 * DM : nullptr); SEAM(); }
        if constexpr ((MASK & PH_INPROJ) != 0) { LAUNDER_ARGS();
            const bool ml = (layer & 1) == 0;
            const bf16* W = ml ? (const bf16*)(A.ws + WS_W_MIN) + (size_t)j * MIN_PAD * DM : (const bf16*)(A.ws + WS_W_AIN) + (size_t)j * AIN * DM;
            const int N = ml ? MIN_PAD : AIN;
            pg8::Gemm g{(const bf16*)(A.ws + WS_HN), W, MT, N, DM, DM}; pg8::StaticOrder S; S.init(MT, N, F.G, (int)blockIdx.x);
            pg8::EpiProj E{(bf16*)(A.ws + WS_PROJ), LDP, (float*)(A.ws + WS_GATES), A.in[IN_MGB] + (size_t)j * 32, ml ? 1 : 0,
                           ml ? 0 : 1, A.in[IN_AQG] + (size_t)j * 128, A.in[IN_AKG] + (size_t)j * 128, (PG8_LAS float*)(F.lds + 131072), ML};
            pg8::gemm_phase<pg8::EpiProj, pg8::StaticOrder, PG8_ALIGN, PG8_SP2>(F.lds, g, S, E, F.wave);
            SEAM();
        }
        if ((layer & 1) == 0) {
            if constexpr ((MASK & PH_SCAN) != 0) { mlstm_scan_phase(F, A_); SEAM(); }
            if constexpr ((MASK & PH_FINISH) != 0) { mlstm_finish_phase(F, A_, j); SEAM(); }
        } else {
            if constexpr ((MASK & PH_ATTN) != 0) { attn_phase(F, A_, layer, j, upd); SEAM(); }
        }
        if constexpr ((MASK & PH_OUTPROJ) != 0) { LAUNDER_ARGS(); const float* MODL = (const float*)(A.ws + WS_MOD) + (size_t)layer * 5 * 12288;
            const bool ml = (layer & 1) == 0;
            const bf16* W = ml ? (const bf16*)(A.ws + WS_W_MOUT) + (size_t)j * DM * DM : (const bf16*)(A.ws + WS_W_AOUT) + (size_t)j * DM * DM;
            pg8::Gemm g{(const bf16*)(A.ws + WS_OB), W, ML, DM, DM, DM}; pg8::PanelOrder S; S.init(ML, DM, F.G, (int)blockIdx.x);
            pg8::EpiResidNorm E{(const unsigned short*)(A.ws + WS_X), (unsigned short*)(A.ws + WS_X), MODL + 2 * DM,
                                (bf16*)(A.ws + WS_HN), A.in[IN_NORMG] + (size_t)(layer * 2 + 1) * DM, MODL + 3 * DM,
                                (unsigned long long*)(A.ws + WS_XBUF), 0x51u + 2u * (unsigned)layer, (unsigned*)(A.ws + WS_CTL) + CW_XTMO, (PG8_LAS float*)(F.lds + 131072)};
            pg8::gemm_phase<pg8::EpiResidNorm, pg8::PanelOrder, PG8_ALIGN, PG8_SP2>(F.lds, g, S, E, F.wave);
            if (upd) {
                pg8::Gemm gc{(const bf16*)(A.ws + WS_OB) + (size_t)ML * DM, W, MC, DM, DM / KSPLIT, DM}; pg8::SplitOrder SC; SC.init(MC, DM, KSPLIT, F.G, (int)blockIdx.x);
                pg8::EpiSlab EC{(float*)(A.ws + WS_SLAB), (size_t)MC * DM};
                pg8::gemm_phase<pg8::EpiSlab, pg8::SplitOrder, PG8_ALIGN, PG8_SP2>(F.lds, gc, SC, EC, F.wave);
            }
            SEAM();
        }
        if constexpr ((MASK & PH_NORM2) != 0) { if (upd) { norm_phase<false>(F, A_, layer, 1, ML, MT, (const float*)(A_.ws + WS_MOD) + (size_t)(layer * 5 + 4) * 12288 + 2 * DM); SEAM(); } }
        if constexpr ((MASK & PH_GU) != 0) { LAUNDER_ARGS();
            pg8::Gemm g{(const bf16*)(A.ws + WS_HN), (const bf16*)(A.ws + WS_W_GU) + (size_t)layer * NGU * DM, mrows, NGU, DM, DM}; pg8::StaticOrder S; S.init(mrows, NGU, F.G, (int)blockIdx.x);
            pg8::EpiSwiGLU E{(bf16*)(A.ws + WS_HID), FFH};
            pg8::gemm_phase<pg8::EpiSwiGLU, pg8::StaticOrder, PG8_ALIGN, PG8_SP2>(F.lds, g, S, E, F.wave);
            SEAM();
        }
        if constexpr ((MASK & PH_DOWN) != 0) { LAUNDER_ARGS(); const float* MODL = (const float*)(A.ws + WS_MOD) + (size_t)layer * 5 * 12288;
            const bf16* WD = (const bf16*)(A.ws + WS_W_DN) + (size_t)layer * DM * FFH;
            pg8::Gemm g{(const bf16*)(A.ws + WS_HID), WD, ML, DM, FFH, FFH};
            if (last) { pg8::StaticOrder S; S.init(ML, DM, F.G, (int)blockIdx.x);
                pg8::EpiResid E{(const unsigned short*)(A.ws + WS_X), (void*)A.out, MODL + 5 * DM, 1};
                pg8::gemm_phase<pg8::EpiResid, pg8::StaticOrder, PG8_ALIGN, PG8_SP2>(F.lds, g, S, E, F.wave);
            } else { pg8::PanelOrder S; S.init(ML, DM, F.G, (int)blockIdx.x);
                pg8::EpiResidNorm E{(const unsigned short*)(A.ws + WS_X), (unsigned short*)(A.ws + WS_X), MODL + 5 * DM,
                                    (bf16*)(A.ws + WS_HN), A.in[IN_NORMG] + (size_t)((layer + 1) * 2) * DM, MODL + 5 * 12288,
                                    (unsigned long long*)(A.ws + WS_XBUF), 0x52u + 2u * (unsigned)layer, (unsigned*)(A.ws + WS_CTL) + CW_XTMO, (PG8_LAS float*)(F.lds + 131072)};
                pg8::gemm_phase<pg8::EpiResidNorm, pg8::PanelOrder, PG8_ALIGN, PG8_SP2>(F.lds, g, S, E, F.wave); }
            if (upd) {
                pg8::Gemm gc{(const bf16*)(A.ws + WS_HID) + (size_t)ML * FFH, WD, MC, DM, FFH / KSPLIT, FFH}; pg8::SplitOrder SC; SC.init(MC, DM, KSPLIT, F.G, (int)blockIdx.x);
                pg8::EpiSlab EC{(float*)(A.ws + WS_SLAB), (size_t)MC * DM};
                pg8::gemm_phase<pg8::EpiSlab, pg8::SplitOrder, PG8_ALIGN, PG8_SP2>(F.lds, gc, SC, EC, F.wave);
            }
            if (!last) SEAM();
        }
    }
#undef SEAM
#undef LAUNDER_ARGS
}
template <int MASK, bool SEAMS>
__device__ __forceinline__ void run_program(Frame& F, const Args& A_, const XcdBarrier& bar, int l0, int l1) {
    if constexpr ((MASK & PH_P0) != 0) { p0_prologue(F, A_, DEPTH); if constexpr (SEAMS) xcd_barrier(bar); }
    if constexpr (SEAMS) {
        run_layer<MASK, SEAMS, 0>(F, A_, bar, 0);
        if constexpr (LASTL >= 1) run_layer<MASK, SEAMS, 1>(F, A_, bar, 1);
        if constexpr (LASTL >= 2) run_layer<MASK, SEAMS, 2>(F, A_, bar, 2);
        if constexpr (LASTL >= 3) run_layer<MASK, SEAMS, 3>(F, A_, bar, 3);
    } else {
        if constexpr ((MASK & ~PH_P0) != 0) for (int layer = l0; layer < l1; ++layer) run_layer<MASK, SEAMS, -1>(F, A_, bar, layer);
    }
}
__device__ __forceinline__ void frame_init(Frame& F, unsigned char* lds_raw) {
    F.lds = (LAS unsigned char*)lds_raw;
    F.MISC = (volatile LAS unsigned*)(F.lds + MISC_OFF);
    F.wave = __builtin_amdgcn_readfirstlane((int)threadIdx.x >> 6);
    F.G = gridDim.x; { const int bx = blockIdx.x; F.vcu = (F.G % 8 == 0) ? (bx % 8) * (F.G / 8) + bx / 8 : bx; }
    if (F.wave == 0) F.MISC[lane_id()] = 0u;
    __syncthreads();
}
#if MK_N_LAUNCHES == 1
__global__ void __launch_bounds__(NWAVES * 64, 2) hybrid_fwd(const Args A) {
    extern __shared__ __attribute__((aligned(16))) unsigned char lds_raw[];
    Frame F; frame_init(F, lds_raw);
    const XcdBarrier bar = xcd_barrier_post((unsigned*)(A.ws + WS_CTL) + CW_BAR, F.MISC + 8, F.wave);
    run_program<PH_ALL, true>(F, A, bar, 0, LASTL + 1);
}
#else
template <int MASK> __global__ void __launch_bounds__(NWAVES * 64, 2) hybrid_phase(const Args A) {
    extern __shared__ __attribute__((aligned(16))) unsigned char lds_raw[];
    Frame F; frame_init(F, lds_raw);
    XcdBarrier bar; bar.bar = nullptr; bar.x = 0; bar.st = F.MISC + 8; bar.wave = F.wave;
    run_program<MASK, false>(F, A, bar, A.ph_lo, A.ph_lo + 1);
}
#endif


#ifndef DBG_DUMP
#define DBG_DUMP 0
#endif
#ifndef DBG_HASH
#define DBG_HASH 0
#endif
#ifndef DBG_LASTPH
#define DBG_LASTPH 7
#endif
#if DBG_DUMP
__global__ void __launch_bounds__(256) dbg_dump(const Args A) {
    const size_t n = (size_t)ML * DM;
    for (size_t i = (size_t)blockIdx.x * 256 + threadIdx.x; i < n; i += (size_t)gridDim.x * 256) {
        const size_t row = i / DM, col = i % DM; float v = 0.f;
        if (DBG_DUMP == 1) v = bf_lo(((const bf16*)(A.ws + WS_HN))[i]);
        if (DBG_DUMP == 2) v = bf_lo(((const bf16*)(A.ws + WS_PROJ))[row * LDP + col]);
        if (DBG_DUMP == 8) v = bf_lo(((const bf16*)(A.ws + WS_PROJ))[row * LDP + 2048 + col]);
        if (DBG_DUMP == 9) v = bf_lo(((const bf16*)(A.ws + WS_PROJ))[row * LDP + 4096 + col]);
        if (DBG_DUMP == 3) v = i < (size_t)MT * 32 ? ((const float*)(A.ws + WS_GATES))[i] : 0.f;
        if (DBG_DUMP == 11) v = i < (size_t)MIN_REAL * DM ? bf_lo(((const bf16*)(A.ws + WS_W_MIN))[(size_t)MIN_PAD * DM + i]) : 0.f;
        if (DBG_DUMP == 6) v = bf_lo(((const bf16*)(A.ws + WS_OB))[i]);
        if (DBG_DUMP == 7) v = h_lo((unsigned)((const unsigned short*)(A.ws + WS_X))[i]);
        if (DBG_HASH) v = (float)(__float_as_uint(v) >> 16 & 0xFFu) + (float)(__float_as_uint(v) & 0xFFu);
        A.out[i] = v;
    }
}
#endif

template <class K> static bool prep_kernel(K kern) {
    if (hipFuncSetAttribute((const void*)kern, hipFuncAttributeMaxDynamicSharedMemorySize, LDS_BYTES) != hipSuccess) { fprintf(stderr, "kernel_launch: hipFuncSetAttribute failed\n"); return false; }
    return true;
}
extern "C" void kernel_launch(void* const* d_in, const int* in_sizes, int n_in, void* d_out, int out_size, void* d_ws, size_t ws_size, hipStream_t stream) {
    static int grid = 0;
    if (grid == 0) {
        if (n_in != 22 || out_size != ML * DM || ws_size < WS_END) { fprintf(stderr, "kernel_launch: built for 22 inputs, %d outputs, >= %zu bytes of workspace; got n_in %d, out %d, ws %zu; nothing launched\n", ML * DM, (size_t)WS_END, n_in, out_size, ws_size); grid = -1; return; }
        int dev = 0, cus = 0;
        if (hipGetDevice(&dev) != hipSuccess || hipDeviceGetAttribute(&cus, hipDeviceAttributeMultiprocessorCount, dev) != hipSuccess) { fprintf(stderr, "kernel_launch: device query failed\n"); grid = -1; return; }
        if (cus != 256) { fprintf(stderr, "kernel_launch: built for 256 CUs (the fused-norm epilogue's tile owners must share a round), device has %d; nothing launched\n", cus); grid = -1; return; }
        bool ok = true;
#if MK_N_LAUNCHES == 1
        ok = prep_kernel(hybrid_fwd);
        int per_cu = 0;
        if (hipOccupancyMaxActiveBlocksPerMultiprocessor(&per_cu, (const void*)hybrid_fwd, NWAVES * 64, LDS_BYTES) != hipSuccess || per_cu < 1) fprintf(stderr, "kernel_launch: note: occupancy query reports %d workgroups per CU\n", per_cu);
        (void)hipGetLastError();
#else
        ok = prep_kernel(hybrid_phase<PH_P0>) && prep_kernel(hybrid_phase<PH_NORM1>) && prep_kernel(hybrid_phase<PH_INPROJ>) && prep_kernel(hybrid_phase<PH_SCAN>) && prep_kernel(hybrid_phase<PH_FINISH>) && prep_kernel(hybrid_phase<PH_QKNORM>)
          && prep_kernel(hybrid_phase<PH_ATTN>) && prep_kernel(hybrid_phase<PH_OUTPROJ>) && prep_kernel(hybrid_phase<PH_NORM2>) && prep_kernel(hybrid_phase<PH_GU>) && prep_kernel(hybrid_phase<PH_DOWN>);
#endif
        if (!ok) { grid = -1; return; }
        grid = cus;
    }
    if (grid < 0) return;
    if (hipMemsetAsync((char*)d_ws + WS_CTL, 0, CTL_ZERO_BYTES, stream) != hipSuccess) { fprintf(stderr, "kernel_launch: memset failed\n"); return; }
    Args a{};
    for (int i = 0; i < 22; ++i) a.in[i] = (const float*)d_in[i];
    a.out = (float*)d_out; a.ws = (unsigned char*)d_ws; a.ph_lo = 0; a.ph_hi = 0;
    const dim3 gd(grid), bd(NWAVES * 64);
#if MK_N_LAUNCHES == 1
    hipLaunchKernelGGL(hybrid_fwd, gd, bd, LDS_BYTES, stream, a);
#else
#define LAUNCH(M) do { for (int rp_ = REPS(M) - 1; rp_ >= 0; --rp_) { a.ph_hi = rp_; hipLaunchKernelGGL(hybrid_phase<M>, gd, bd, LDS_BYTES, stream, a); } } while (0)
    LAUNCH(PH_P0);
    for (int layer = 0; layer <= LASTL; ++layer) {
        a.ph_lo = layer;
        const int lastph = (layer == LASTL) ? DBG_LASTPH : 7;
        LAUNCH(PH_NORM1); if (lastph < 1) break; LAUNCH(PH_INPROJ); if (lastph < 2) break;
        if ((layer & 1) == 0) { LAUNCH(PH_SCAN); if (lastph < 3) break; LAUNCH(PH_FINISH); } else { if (lastph < 3) break; LAUNCH(PH_ATTN); }
        if (lastph < 4) break;
        LAUNCH(PH_OUTPROJ); if (lastph < 5) break; LAUNCH(PH_NORM2); if (lastph < 6) break; LAUNCH(PH_GU); if (lastph < 7) break; LAUNCH(PH_DOWN);
    }
#if DBG_DUMP
    hipLaunchKernelGGL(dbg_dump, dim3(2048), dim3(256), 0, stream, a);
#endif
#undef LAUNCH
#endif
    const hipError_t le = hipPeekAtLastError();
    if (le != hipSuccess) fprintf(stderr, "kernel_launch: launch failed: %s\n", hipGetErrorName(le));
}
```

```cpp
#include <hip/hip_runtime.h>
#include <cstdio>
#include <cstdint>
typedef __bf16 bf16x2_hw __attribute__((ext_vector_type(2)));
typedef float f32x2_hw __attribute__((ext_vector_type(2)));
__device__ __forceinline__ unsigned cvt_pk_bf16_hw(float lo, float hi) { const f32x2_hw v = {lo, hi}; const bf16x2_hw r = __builtin_convertvector(v, bf16x2_hw); return __builtin_bit_cast(unsigned, r); }
__device__ __forceinline__ int lane_id() { int l; asm volatile("v_mbcnt_lo_u32_b32 %0, -1, 0\n\tv_mbcnt_hi_u32_b32 %0, -1, %0" : "=v"(l)); return l & 63; }
typedef _Float16 f16x2_hw __attribute__((ext_vector_type(2)));
__device__ __forceinline__ unsigned pkh2(float lo, float hi) { lo = __builtin_amdgcn_fmed3f(lo, -65000.0f, 65000.0f); hi = __builtin_amdgcn_fmed3f(hi, -65000.0f, 65000.0f);
    const f32x2_hw v = {lo, hi}; const f16x2_hw r = __builtin_convertvector(v, f16x2_hw); return __builtin_bit_cast(unsigned, r); }
__device__ __forceinline__ float h_lo(unsigned w) { const f16x2_hw r = __builtin_bit_cast(f16x2_hw, w); return (float)r[0]; }
__device__ __forceinline__ float h_hi(unsigned w) { const f16x2_hw r = __builtin_bit_cast(f16x2_hw, w); return (float)r[1]; }
namespace pg8 {
#define PG8_LAS __attribute__((address_space(3)))
typedef unsigned short bf16_t;
typedef short bf16x8 __attribute__((ext_vector_type(8)));
typedef float f32x4 __attribute__((ext_vector_type(4)));
typedef unsigned u32x4 __attribute__((ext_vector_type(4)));
constexpr int BM = 256, BK = 64, HALF = 128, HTB = HALF * BK * 2  , STAGE_BYTES = 8 * HTB, NXCD = 8, WGM = 8;

__host__ __device__ __forceinline__ int lds_byte(int r, int c) { const int st = (r >> 4) * 2 + (c >> 5), rr = r & 15, cc = c & 31, ob = rr * 64 + cc * 2; return st * 1024 + (ob ^ (((ob >> 9) & 1) << 5)); }
__host__ __device__ __forceinline__ void stage_rc(int b, int& R, int& C) { const int st = b / 1024, sb = b % 1024, swz = sb ^ (((sb >> 9) & 1) << 5); R = (st >> 1) * 16 + swz / 64; C = (st & 1) * 32 + (swz % 64) / 2; }
__host__ __device__ __forceinline__ int perm32(int rho) { const int n = rho >> 4, i = rho & 15; return 8 * (i >> 2) + 4 * n + (i & 3); }

struct Unit { int pm, pn, ks; };
struct Gemm { const bf16_t* A; const bf16_t* Bt; int M, N, K, ld; };

struct StaticOrder {
    int nM, nN, nwg, G, c;
    __host__ __device__ void init(int M, int N, int G_, int c_) { nM = M / BM; nN = N / BM; nwg = nM * nN; G = G_; c = c_; }
    __host__ __device__ bool next(int i, Unit& u) const {
        const long L = (long)i * G + c; if (L >= nwg) return false;
        int wgid = (int)L; { const int q = nwg / NXCD, r = nwg % NXCD, xcd = wgid % NXCD, off = wgid / NXCD; wgid = (xcd < r ? xcd * (q + 1) : r * (q + 1) + (xcd - r) * q) + off; }
        const int nig = WGM * nN, gid = wgid / nig, fm = gid * WGM, gsz = (nM - fm) < WGM ? (nM - fm) : WGM;
        u.pm = fm + ((wgid % nig) % gsz); u.pn = (wgid % nig) / gsz; u.ks = 0; return true;
    }
    __device__ __forceinline__ void a_ready(const Unit&) const {}
    __device__ __forceinline__ void done(const Unit&) const {}
};
struct PanelOrder {
    int nM, nN, nwg, G, c;
    __host__ __device__ void init(int M, int N, int G_, int c_) { nM = M / BM; nN = N / BM; nwg = nM * nN; G = G_; c = c_; }
    __host__ __device__ bool next(int i, Unit& u) const {
        const long L = (long)i * G + c; if (L >= nwg) return false;
        int wgid = (int)L; { const int q = nwg / NXCD, r = nwg % NXCD, xcd = wgid % NXCD, off = wgid / NXCD; wgid = (xcd < r ? xcd * (q + 1) : r * (q + 1) + (xcd - r) * q) + off; }
        u.pm = wgid / nN; u.pn = wgid % nN; u.ks = 0; return true;
    }
    __device__ __forceinline__ void a_ready(const Unit&) const {}
    __device__ __forceinline__ void done(const Unit&) const {}
};
struct SplitOrder {
    int nM, nN, nS, G, c;
    __host__ __device__ void init(int M, int N, int nS_, int G_, int c_) { nM = M / BM; nN = N / BM; nS = nS_; G = G_; c = c_; }
    __host__ __device__ bool next(int i, Unit& u) const {
        const int L = i * G + c; if (L >= nM * nN * nS) return false;
        u.ks = L / (nM * nN); const int rem = L % (nM * nN); u.pn = rem / nM; u.pm = rem % nM; return true;
    }
    __device__ __forceinline__ void a_ready(const Unit&) const {}
    __device__ __forceinline__ void done(const Unit&) const {}
};


__device__ __forceinline__ unsigned cvt_pk_bf16(float lo, float hi) { return cvt_pk_bf16_hw(lo, hi); }
typedef float f32x2 __attribute__((ext_vector_type(2)));
__device__ __forceinline__ float softcap15(float x) { return 15.0f * tanhf(x * (1.0f / 15.0f)); }
__device__ __forceinline__ float log_sigmoid(float x) { return fminf(x, 0.f) - log1pf(__expf(-fabsf(x))); }
struct EpiProj {
    static constexpr bool PERM = true, AFTER_DRAIN = false;
    bf16_t* O; int ldc; float* gates; const float* gate_b; int mlstm;
    int attn; const float* qg; const float* kg; PG8_LAS float* P; int nrope;
    __device__ __forceinline__ void operator()(const f32x4 (&acc)[2][2][4][2], const Unit& u, int wr, int wc, int fr, int fq) const {
        const int row0 = u.pm * BM + wr * 64 + fr;
        if (attn && u.pn < 16) {
            const bool isq = u.pn < 8; const float* G = isq ? qg : kg;
            const int half = wc >> 1, fb = 16 * (wc & 1) + 4 * fq;
#pragma unroll
            for (int ai = 0; ai < 2; ++ai)
#pragma unroll
                for (int m = 0; m < 4; ++m)
#pragma unroll
                    for (int bj = 0; bj < 2; ++bj) { const f32x4 a = acc[ai][bj][m][0], b = acc[ai][bj][m][1];
                        float s = (a[0] * a[0] + a[1] * a[1]) + (a[2] * a[2] + a[3] * a[3]) + (b[0] * b[0] + b[1] * b[1]) + (b[2] * b[2] + b[3] * b[3]);
                        s += __shfl_xor(s, 16); s += __shfl_xor(s, 32);
                        if (fq == 0) P[(ai * HALF + wr * 64 + m * 16 + fr) * 8 + bj * 4 + wc] = s; }
            asm volatile("s_waitcnt lgkmcnt(0)" ::: "memory"); __builtin_amdgcn_s_barrier(); asm volatile("" ::: "memory");
            const f32x4 g1 = *(const f32x4*)(G + half * 64 + fb), g2 = *(const f32x4*)(G + half * 64 + 32 + fb);
            float frq[4];
#pragma unroll
            for (int i = 0; i < 4; ++i) frq[i] = exp2f(-(float)(fb + i) * (13.287712379549449f / 32.0f)) * 0.15915494309189535f;
            const float qs = isq ? (0.08838834764831845f * 1.4426950408889634f) : 1.0f;
            const int col0 = u.pn * BM + wc * 32 + 8 * fq;
#pragma unroll
            for (int ai = 0; ai < 2; ++ai)
#pragma unroll
                for (int m = 0; m < 4; ++m) { const int rl = ai * HALF + wr * 64 + m * 16 + fr, row = u.pm * BM + rl;
                    float cs[4], sn[4];
                    if (row < nrope) { const int sq = row & 4095; const float pos = (float)(half ? (sq & 63) : (sq >> 6));
#pragma unroll
                        for (int i = 0; i < 4; ++i) { float rev = pos * frq[i]; rev -= rintf(rev); cs[i] = __builtin_amdgcn_cosf(rev); sn[i] = __builtin_amdgcn_sinf(rev); } }
                    else {
#pragma unroll
                        for (int i = 0; i < 4; ++i) { cs[i] = 1.f; sn[i] = 0.f; } }
                    bf16_t* rowp = O + (size_t)row * ldc + col0;
#pragma unroll
                    for (int bj = 0; bj < 2; ++bj) { const f32x4 p4 = *(const PG8_LAS f32x4*)(P + rl * 8 + bj * 4);
                        const float rs = __builtin_amdgcn_rsqf(((p4[0] + p4[1]) + (p4[2] + p4[3])) * (1.0f / 128.0f) + 1e-6f) * qs;
                        const f32x4 v0 = acc[ai][bj][m][0], v1 = acc[ai][bj][m][1];
                        const float x1[4] = {v0[0], v0[2], v1[0], v1[2]}, x2[4] = {v0[1], v0[3], v1[1], v1[3]};
                        float o1[4], o2[4];
#pragma unroll
                        for (int i = 0; i < 4; ++i) { const float y1 = x1[i] * rs * g1[i], y2 = x2[i] * rs * g2[i]; o1[i] = y1 * cs[i] - y2 * sn[i]; o2[i] = y2 * cs[i] + y1 * sn[i]; }
                        u32x4 w; w.x = cvt_pk_bf16(o1[0], o2[0]); w.y = cvt_pk_bf16(o1[1], o2[1]); w.z = cvt_pk_bf16(o1[2], o2[2]); w.w = cvt_pk_bf16(o1[3], o2[3]);
                        *(u32x4*)(rowp + bj * HALF) = w; } }
            return;
        }
        if (mlstm && u.pn == 24) {
            if (wc == 0) {
                const f32x4 b0 = *(const f32x4*)(gate_b + 8 * fq), b1 = *(const f32x4*)(gate_b + 8 * fq + 4);
#pragma unroll
                for (int ai = 0; ai < 2; ++ai)
#pragma unroll
                    for (int m = 0; m < 4; ++m) { float* gp = gates + (size_t)(row0 + ai * HALF + m * 16) * 32 + 8 * fq;
                        f32x4 v0 = acc[ai][0][m][0] + b0, v1 = acc[ai][0][m][1] + b1;
#pragma unroll
                        for (int j = 0; j < 4; ++j) { v0[j] = softcap15(v0[j]); v1[j] = softcap15(v1[j]); if (fq & 1) { v0[j] = log_sigmoid(v0[j]); v1[j] = log_sigmoid(v1[j]); } }
                        *(f32x4*)gp = v0; *(f32x4*)(gp + 4) = v1; }
            }
            return;
        }
        const float sc = (mlstm && u.pn < 4) ? 0.08838834764831845f : 1.0f;
        const int col0 = u.pn * BM + wc * 32 + 8 * fq;
#pragma unroll
        for (int ai = 0; ai < 2; ++ai)
#pragma unroll
            for (int m = 0; m < 4; ++m) { bf16_t* rowp = O + (size_t)(row0 + ai * HALF + m * 16) * ldc + col0;
#pragma unroll
                for (int bj = 0; bj < 2; ++bj) { const f32x4 v0 = acc[ai][bj][m][0] * sc, v1 = acc[ai][bj][m][1] * sc;
                    u32x4 w; w.x = cvt_pk_bf16(v0[0], v0[1]); w.y = cvt_pk_bf16(v0[2], v0[3]); w.z = cvt_pk_bf16(v1[0], v1[1]); w.w = cvt_pk_bf16(v1[2], v1[3]);
                    *(u32x4*)(rowp + bj * HALF) = w; } }
    }
};
struct EpiResid {
    static constexpr bool PERM = true, AFTER_DRAIN = false;
    const unsigned short* base; void* out; const float* gate; int fin;
    __device__ __forceinline__ void operator()(const f32x4 (&acc)[2][2][4][2], const Unit& u, int wr, int wc, int fr, int fq) const {
        const int row0 = u.pm * BM + wr * 64 + fr, col0 = u.pn * BM + wc * 32 + 8 * fq;
        const float* gp = gate + (size_t)(u.pm < 64 ? (u.pm >> 4) : 4) * 12288 + col0;
        f32x4 gv[2][2];
#pragma unroll
        for (int bj = 0; bj < 2; ++bj)
#pragma unroll
            for (int n = 0; n < 2; ++n) gv[bj][n] = *(const f32x4*)(gp + bj * HALF + 4 * n);
#pragma unroll
        for (int ai = 0; ai < 2; ++ai)
#pragma unroll
            for (int m = 0; m < 4; ++m) { const size_t off = (size_t)(row0 + ai * HALF + m * 16) * 2048 + col0;
                u32x4 bs[2];
#pragma unroll
                for (int bj = 0; bj < 2; ++bj) bs[bj] = *(const u32x4*)(base + off + bj * HALF);
#pragma unroll
                for (int bj = 0; bj < 2; ++bj) {
                    f32x4 r0, r1;
                    r0[0] = h_lo(bs[bj].x); r0[1] = h_hi(bs[bj].x); r0[2] = h_lo(bs[bj].y); r0[3] = h_hi(bs[bj].y);
                    r1[0] = h_lo(bs[bj].z); r1[1] = h_hi(bs[bj].z); r1[2] = h_lo(bs[bj].w); r1[3] = h_hi(bs[bj].w);
                    r0 += gv[bj][0] * acc[ai][bj][m][0]; r1 += gv[bj][1] * acc[ai][bj][m][1];
                    if (fin) { float* op = (float*)out + off + bj * HALF; *(f32x4*)op = r0; *(f32x4*)(op + 4) = r1; }
                    else { u32x4 w; w.x = pkh2(r0[0], r0[1]); w.y = pkh2(r0[2], r0[3]); w.z = pkh2(r1[0], r1[1]); w.w = pkh2(r1[2], r1[3]);
                        *(u32x4*)((unsigned short*)out + off + bj * HALF) = w; } }
                asm volatile("" ::: "memory"); }
    }
};
struct EpiResidNorm {
    static constexpr bool PERM = true, AFTER_DRAIN = false;
    const unsigned short* base; unsigned short* out; const float* gate;
    bf16_t* hn; const float* ngain; const float* nmod;
    unsigned long long* xbuf; unsigned tag; unsigned* tmo; PG8_LAS float* P;
    __device__ __forceinline__ void operator()(const f32x4 (&acc)[2][2][4][2], const Unit& u, int wr, int wc, int, int) const {
        const int lane2 = lane_id(), fr = lane2 & 15, fq = lane2 >> 4;
        const int row0 = u.pm * BM + wr * 64 + fr, col0 = u.pn * BM + wc * 32 + 8 * fq;
        const int mrow = u.pm < 64 ? (u.pm >> 4) : 4;
        f32x4 xn[2][2][4][2];
        {
            const float* gp = gate + (size_t)mrow * 12288 + col0;
            f32x4 gv[2][2];
#pragma unroll
            for (int bj = 0; bj < 2; ++bj)
#pragma unroll
                for (int n = 0; n < 2; ++n) gv[bj][n] = *(const f32x4*)(gp + bj * HALF + 4 * n);
#pragma unroll
            for (int ai = 0; ai < 2; ++ai)
#pragma unroll
                for (int m = 0; m < 4; ++m) { const size_t off = (size_t)(row0 + ai * HALF + m * 16) * 2048 + col0;
                    u32x4 bs[2]; float s = 0.f;
#pragma unroll
                    for (int bj = 0; bj < 2; ++bj) bs[bj] = *(const u32x4*)(base + off + bj * HALF);
#pragma unroll
                    for (int bj = 0; bj < 2; ++bj) {
                        f32x4 r0, r1;
                        r0[0] = h_lo(bs[bj].x); r0[1] = h_hi(bs[bj].x); r0[2] = h_lo(bs[bj].y); r0[3] = h_hi(bs[bj].y);
                        r1[0] = h_lo(bs[bj].z); r1[1] = h_hi(bs[bj].z); r1[2] = h_lo(bs[bj].w); r1[3] = h_hi(bs[bj].w);
                        r0 += gv[bj][0] * acc[ai][bj][m][0]; r1 += gv[bj][1] * acc[ai][bj][m][1];
                        u32x4 w; w.x = pkh2(r0[0], r0[1]); w.y = pkh2(r0[2], r0[3]); w.z = pkh2(r1[0], r1[1]); w.w = pkh2(r1[2], r1[3]);
                        *(u32x4*)(out + off + bj * HALF) = w;
                        xn[ai][bj][m][0] = r0; xn[ai][bj][m][1] = r1;
                        s += ((r0[0] * r0[0] + r0[1] * r0[1]) + (r0[2] * r0[2] + r0[3] * r0[3])) + ((r1[0] * r1[0] + r1[1] * r1[1]) + (r1[2] * r1[2] + r1[3] * r1[3])); }
                    s += __shfl_xor(s, 16); s += __shfl_xor(s, 32);
                    if (fq == 0) P[(ai * HALF + wr * 64 + m * 16 + fr) * 4 + wc] = s;
                    asm volatile("" ::: "memory"); }
        }
        asm volatile("s_waitcnt lgkmcnt(0)" ::: "memory"); __builtin_amdgcn_s_barrier(); asm volatile("" ::: "memory");
        const int wid = wr * 4 + wc, lane = fq * 16 + fr, row = wid * 32 + (lane & 31);
        unsigned long long* slot = xbuf + ((size_t)u.pm * 2048 + row);
        if (lane < 32) { const f32x4 p4 = *(const PG8_LAS f32x4*)(P + row * 4);
            __hip_atomic_store(slot + u.pn * 256, ((unsigned long long)tag << 32) | (unsigned long long)__builtin_bit_cast(unsigned, (p4[0] + p4[1]) + (p4[2] + p4[3])), __ATOMIC_RELAXED, __HIP_MEMORY_SCOPE_AGENT); }
        f32x4 SH[2][2];
        { const float* md = nmod + (size_t)mrow * 12288 + col0;
#pragma unroll
          for (int bj = 0; bj < 2; ++bj)
#pragma unroll
            for (int n = 0; n < 2; ++n) { const f32x4 g = *(const f32x4*)(ngain + col0 + bj * HALF + 4 * n), sc = *(const f32x4*)(md + 2048 + bj * HALF + 4 * n);
                const f32x4 gg = g * (sc + 1.0f); SH[bj][n] = *(const f32x4*)(md + bj * HALF + 4 * n);
#pragma unroll
                for (int ai = 0; ai < 2; ++ai)
#pragma unroll
                    for (int m = 0; m < 4; ++m) xn[ai][bj][m][n] *= gg; } }
        if (lane < 32) { unsigned sp = 0u; float t;
            for (;;) { bool ok = true; t = 0.f;
#pragma unroll
                for (int k = 0; k < 8; ++k) { const unsigned long long w = __hip_atomic_load(slot + k * 256, __ATOMIC_RELAXED, __HIP_MEMORY_SCOPE_AGENT); ok = ok && ((unsigned)(w >> 32) == tag); t += __builtin_bit_cast(float, (unsigned)w); }
                if (__builtin_amdgcn_ballot_w64(!ok) == 0ull) break;
                __builtin_amdgcn_s_sleep(1);
                if ((++sp & 255u) == 0u) { if (__hip_atomic_load(tmo, __ATOMIC_RELAXED, __HIP_MEMORY_SCOPE_AGENT)) break; if (sp > (1u << 20)) { __hip_atomic_store(tmo, 1u, __ATOMIC_RELAXED, __HIP_MEMORY_SCOPE_AGENT); break; } } }
            P[1024 + row] = 1.0f / sqrtf(t * (1.0f / 2048.0f) + 1e-6f); }
        asm volatile("s_waitcnt lgkmcnt(0)" ::: "memory"); __builtin_amdgcn_s_barrier(); asm volatile("" ::: "memory");
#pragma unroll
        for (int ai = 0; ai < 2; ++ai)
#pragma unroll
            for (int m = 0; m < 4; ++m) { const int rl = ai * HALF + wr * 64 + m * 16 + fr; const float rs = P[1024 + rl];
                bf16_t* rowp = hn + (size_t)(u.pm * BM + rl) * 2048 + col0;
#pragma unroll
                for (int bj = 0; bj < 2; ++bj) { const f32x4 y0 = xn[ai][bj][m][0] * rs + SH[bj][0], y1 = xn[ai][bj][m][1] * rs + SH[bj][1];
                    u32x4 w; w.x = cvt_pk_bf16(y0[0], y0[1]); w.y = cvt_pk_bf16(y0[2], y0[3]); w.z = cvt_pk_bf16(y1[0], y1[1]); w.w = cvt_pk_bf16(y1[2], y1[3]);
                    *(u32x4*)(rowp + bj * HALF) = w; } }
    }
};
struct EpiSwiGLU {
    static constexpr bool PERM = true, AFTER_DRAIN = false;
    bf16_t* Hd; int ldh;
    __device__ __forceinline__ void operator()(const f32x4 (&acc)[2][2][4][2], const Unit& u, int wr, int wc, int fr, int fq) const {
        const int row0 = u.pm * BM + wr * 64 + fr, col0 = u.pn * HALF + wc * 32 + 8 * fq;
#pragma unroll
        for (int ai = 0; ai < 2; ++ai)
#pragma unroll
            for (int m = 0; m < 4; ++m) { float r[8];
#pragma unroll
                for (int n = 0; n < 2; ++n)
#pragma unroll
                    for (int j = 0; j < 4; ++j) { const float g = acc[ai][0][m][n][j], up = acc[ai][1][m][n][j]; r[4 * n + j] = g * __builtin_amdgcn_rcpf(1.0f + __expf(-g)) * up; }
                u32x4 w; w.x = cvt_pk_bf16(r[0], r[1]); w.y = cvt_pk_bf16(r[2], r[3]); w.z = cvt_pk_bf16(r[4], r[5]); w.w = cvt_pk_bf16(r[6], r[7]);
                *(u32x4*)(Hd + (size_t)(row0 + ai * HALF + m * 16) * ldh + col0) = w; }
    }
};

struct EpiSlab {
    static constexpr bool PERM = false, AFTER_DRAIN = false;
    float* slab; size_t ks_stride;
    __device__ __forceinline__ void operator()(const f32x4 (&acc)[2][2][4][2], const Unit& u, int wr, int wc, int fr, int fq) const {
        const int row0 = u.pm * BM + wr * 64 + fr, col0 = u.pn * BM + wc * 32 + 4 * fq;
        float* sp = slab + (size_t)u.ks * ks_stride;
#pragma unroll
        for (int ai = 0; ai < 2; ++ai)
#pragma unroll
            for (int m = 0; m < 4; ++m) { const size_t off = (size_t)(row0 + ai * HALF + m * 16) * 2048 + col0;
#pragma unroll
                for (int bj = 0; bj < 2; ++bj)
#pragma unroll
                    for (int n = 0; n < 2; ++n) *(f32x4*)(sp + off + bj * HALF + n * 16) = acc[ai][bj][m][n]; }
    }
};

template <class Epi, class Sched, bool ALIGN_EPI = false, bool SP2 = false>
__device__ __forceinline__ void gemm_phase(PG8_LAS unsigned char* lds, const Gemm g, const Sched& S, const Epi& E, const int wave_in) {
    const int lane = lane_id(), wid = wave_in, tid = wid * 64 + lane,
              wr = wid >> 2, wc = wid & 3, fr = lane & 15, fq = lane >> 4;
    const int K = g.ld, nt = g.K / BK;
    unsigned voffA[2], voffB[2];
#pragma unroll
    for (int i = 0; i < 2; ++i) { int R, C; stage_rc(tid * 16 + i * 8192, R, C); const int Rb = Epi::PERM ? ((R & ~31) + perm32(R & 31)) : R;
        voffA[i] = (unsigned)(R * K + C) * 2u; voffB[i] = (unsigned)(Rb * K + C) * 2u; }
    const size_t kstep = (size_t)(BK * 2);
    const size_t hstep = (size_t)HALF * K * 2;
    const size_t tstep = 2 * hstep;
    const unsigned ldsw = (unsigned)wid * 1024u;
    const int aoff = lds_byte(wr * 64 + fr, fq * 8), boff = lds_byte(wc * 32 + fr, fq * 8);
#define PG8_SA(b, h) (((b) * 2 + (h)) * HTB)
#define PG8_SB(b, h) ((4 + (b) * 2 + (h)) * HTB)
#define PG8_STAGE(bufoff, gbase, voff) do { _Pragma("unroll") for (int _i = 0; _i < 2; ++_i) \
        __builtin_amdgcn_global_load_lds((const unsigned*)((const char*)(gbase) + (voff)[_i]), (PG8_LAS unsigned*)(lds + (bufoff) + ldsw + _i * 8192), 16, 0, 0); } while (0)
#define PG8_LDA(dst, b, h) do { _Pragma("unroll") for (int m = 0; m < 4; ++m) _Pragma("unroll") for (int k = 0; k < 2; ++k) dst[m][k] = *(const PG8_LAS bf16x8*)(lds + PG8_SA(b, h) + aoff + m * 2048 + k * 1024); } while (0)
#define PG8_LDB(dst, b, h) do { _Pragma("unroll") for (int n = 0; n < 2; ++n) _Pragma("unroll") for (int k = 0; k < 2; ++k) dst[n][k] = *(const PG8_LAS bf16x8*)(lds + PG8_SB(b, h) + boff + n * 2048 + k * 1024); } while (0)
#define PG8_MMA(ai, bj, At, Bt) do { __builtin_amdgcn_s_setprio(1); _Pragma("unroll") for (int m = 0; m < 4; ++m) _Pragma("unroll") for (int n = 0; n < 2; ++n) _Pragma("unroll") for (int k = 0; k < 2; ++k) \
        acc[ai][bj][m][n] = __builtin_amdgcn_mfma_f32_16x16x32_bf16(Bt[n][k], At[m][k], acc[ai][bj][m][n], 0, 0, 0); __builtin_amdgcn_s_setprio(0); } while (0)
#define PG8_WAIT_V(n) asm volatile("s_waitcnt vmcnt(" #n ")" ::: "memory")
#define PG8_WAIT_L(n) asm volatile("s_waitcnt lgkmcnt(" #n ")" ::: "memory")
#define PG8_BAR __builtin_amdgcn_s_barrier()
#define PG8_SCHED __builtin_amdgcn_sched_barrier(0)
    Unit cur, nxt; int ui = 0;
    if (!S.next(0, cur)) return;
    f32x4 acc[2][2][4][2];
#pragma unroll
    for (int a = 0; a < 2; ++a)
#pragma unroll
        for (int b = 0; b < 2; ++b)
#pragma unroll
            for (int m = 0; m < 4; ++m)
#pragma unroll
                for (int n = 0; n < 2; ++n) acc[a][b][m][n] = (f32x4){0.f, 0.f, 0.f, 0.f};
    bf16x8 At[4][2], B0[2][2], B1[2][2];
    const size_t kspl = (size_t)g.K * 2;
    const char* cA = (const char*)g.A + (size_t)cur.pm * tstep + (size_t)cur.ks * kspl; const char* cB = (const char*)g.Bt + (size_t)cur.pn * tstep + (size_t)cur.ks * kspl;
    S.a_ready(cur);
    if constexpr (SP2) {
        PG8_STAGE(PG8_SB(0, 0), cB, voffB); PG8_STAGE(PG8_SB(0, 1), cB + hstep, voffB); PG8_STAGE(PG8_SA(0, 0), cA, voffA); PG8_STAGE(PG8_SA(0, 1), cA + hstep, voffA);
        if (wr == 1) PG8_BAR;
        PG8_WAIT_V(2); PG8_BAR;
        PG8_STAGE(PG8_SB(1, 0), cB + kstep, voffB); PG8_STAGE(PG8_SA(1, 0), cA + kstep, voffA); PG8_STAGE(PG8_SB(1, 1), cB + hstep + kstep, voffB);
        PG8_WAIT_V(6); PG8_BAR;
    } else {
        PG8_STAGE(PG8_SB(0, 0), cB, voffB); PG8_STAGE(PG8_SA(0, 0), cA, voffA); PG8_STAGE(PG8_SB(0, 1), cB + hstep, voffB); PG8_STAGE(PG8_SA(0, 1), cA + hstep, voffA);
        if (wr == 1) PG8_BAR;
        PG8_WAIT_V(4); PG8_BAR;
        PG8_STAGE(PG8_SB(1, 0), cB + kstep, voffB); PG8_STAGE(PG8_SA(1, 0), cA + kstep, voffA); PG8_STAGE(PG8_SB(1, 1), cB + hstep + kstep, voffB);
        PG8_WAIT_V(6); PG8_BAR;
    }
    for (;;) {
        const bool has_next = S.next(ui + 1, nxt);
        const char* nA = has_next ? (const char*)g.A + (size_t)nxt.pm * tstep + (size_t)nxt.ks * kspl : cA; const char* nB = has_next ? (const char*)g.Bt + (size_t)nxt.pn * tstep + (size_t)nxt.ks * kspl : cB;
        for (int t = 0; t < nt; t += 2) {
            const bool last = (t == nt - 2);
            const char* a1 = cA + (size_t)(t + 1) * kstep;
            const char* a2 = last ? nA : cA + (size_t)(t + 2) * kstep; const char* b2 = last ? nB : cB + (size_t)(t + 2) * kstep;
            const char* a3 = a2 + kstep; const char* b3 = b2 + kstep;
            if (last && has_next) S.a_ready(nxt);
            if constexpr (SP2) {
            PG8_LDB(B0, 0, 0); PG8_LDB(B1, 0, 1); PG8_SCHED; PG8_LDA(At, 0, 0); PG8_STAGE(PG8_SA(1, 1), a1 + hstep, voffA);
            PG8_WAIT_V(8); PG8_WAIT_L(0); PG8_BAR; PG8_MMA(0, 0, At, B0); PG8_MMA(0, 1, At, B1); PG8_BAR; PG8_SCHED;
            PG8_LDA(At, 0, 1); PG8_STAGE(PG8_SB(0, 0), b2, voffB); PG8_STAGE(PG8_SB(0, 1), b2 + hstep, voffB); PG8_STAGE(PG8_SA(0, 0), a2, voffA);
            PG8_WAIT_V(8); PG8_WAIT_L(0); PG8_BAR; PG8_MMA(1, 0, At, B0); PG8_MMA(1, 1, At, B1); PG8_BAR; PG8_SCHED;
            PG8_LDB(B0, 1, 0); PG8_LDB(B1, 1, 1); PG8_SCHED; PG8_LDA(At, 1, 0); PG8_STAGE(PG8_SA(0, 1), a2 + hstep, voffA);
            PG8_WAIT_V(8); PG8_WAIT_L(0); PG8_BAR; PG8_MMA(0, 0, At, B0); PG8_MMA(0, 1, At, B1); PG8_BAR; PG8_SCHED;
            PG8_LDA(At, 1, 1); PG8_STAGE(PG8_SB(1, 0), b3, voffB); PG8_STAGE(PG8_SB(1, 1), b3 + hstep, voffB); PG8_STAGE(PG8_SA(1, 0), a3, voffA);
            PG8_WAIT_V(8); PG8_WAIT_L(0); PG8_BAR; PG8_MMA(1, 0, At, B0); PG8_MMA(1, 1, At, B1); PG8_BAR; PG8_SCHED;
            } else {
            PG8_LDB(B0, 0, 0); PG8_SCHED; PG8_LDA(At, 0, 0); PG8_STAGE(PG8_SA(1, 1), a1 + hstep, voffA);
            PG8_WAIT_L(8); PG8_BAR; PG8_WAIT_L(0); PG8_MMA(0, 0, At, B0); PG8_BAR; PG8_SCHED;
            PG8_LDB(B1, 0, 1); PG8_STAGE(PG8_SB(0, 0), b2, voffB);
            PG8_BAR; PG8_WAIT_L(0); PG8_MMA(0, 1, At, B1); PG8_BAR;
            PG8_LDA(At, 0, 1); PG8_STAGE(PG8_SA(0, 0), a2, voffA);
            PG8_BAR; PG8_WAIT_L(0); PG8_MMA(1, 0, At, B0); PG8_BAR; PG8_SCHED;
            PG8_STAGE(PG8_SB(0, 1), b2 + hstep, voffB);
            PG8_WAIT_V(6); PG8_BAR; PG8_MMA(1, 1, At, B1); PG8_BAR;
            PG8_LDB(B0, 1, 0); PG8_SCHED; PG8_LDA(At, 1, 0); PG8_STAGE(PG8_SA(0, 1), a2 + hstep, voffA);
            PG8_WAIT_L(8); PG8_BAR; PG8_WAIT_L(0); PG8_MMA(0, 0, At, B0); PG8_BAR; PG8_SCHED;
            PG8_LDB(B1, 1, 1); PG8_STAGE(PG8_SB(1, 0), b3, voffB);
            PG8_BAR; PG8_WAIT_L(0); PG8_MMA(0, 1, At, B1); PG8_BAR;
            PG8_LDA(At, 1, 1); PG8_STAGE(PG8_SA(1, 0), a3, voffA);
            PG8_BAR; PG8_WAIT_L(0); PG8_MMA(1, 0, At, B0); PG8_BAR; PG8_SCHED;
            PG8_STAGE(PG8_SB(1, 1), b3 + hstep, voffB);
            PG8_WAIT_V(6); PG8_BAR; PG8_MMA(1, 1, At, B1); PG8_BAR;
            }
        }
        if constexpr (ALIGN_EPI) { if (wr == 0) PG8_BAR; }
        if constexpr (!Epi::AFTER_DRAIN) { E(acc, cur, wr, wc, fr, fq); S.done(cur); }
        if (!has_next) break;
#pragma unroll
        for (int a = 0; a < 2; ++a)
#pragma unroll
            for (int b = 0; b < 2; ++b)
#pragma unroll
                for (int m = 0; m < 4; ++m)
#pragma unroll
                    for (int n = 0; n < 2; ++n) acc[a][b][m][n] = (f32x4){0.f, 0.f, 0.f, 0.f};
        cur = nxt; cA = nA; cB = nB; ++ui;
        if constexpr (ALIGN_EPI) { if (wr == 1) PG8_BAR; }
    }
    PG8_WAIT_V(0);
    if constexpr (!ALIGN_EPI) { if (wr == 0) PG8_BAR; }
    PG8_BAR;
    if constexpr (Epi::AFTER_DRAIN) { E.fused(acc, cur, wr, wc, fr, fq, lds, wid, lane); S.done(cur); }
#undef PG8_SA
#undef PG8_SB
#undef PG8_STAGE
#undef PG8_LDA
#undef PG8_LDB
#undef PG8_MMA
#undef PG8_WAIT_V
#undef PG8_WAIT_L
#undef PG8_BAR
#undef PG8_SCHED
}
}

#ifndef PG8_SP2
#define PG8_SP2 true
#endif
#ifndef PG8_ALIGN
#define PG8_ALIGN true
#endif
constexpr int NWAVES = 8;
constexpr int DM = 2048, NB = 4, SEQ = 4096, CTXL = 256, DEPTH = 4;
constexpr int ML = NB * SEQ, MC = NB * CTXL, MT = ML + MC;
constexpr int NHEAD = 8, DKH = 128, DVH = 256;
constexpr int MIN_REAL = 6176, MIN_PAD = 6400, AIN = 6144, LDP = 6400;
constexpr int FFH = 5632, NGU = 2 * FFH;
constexpr float EPS = 1e-6f;
constexpr int N_PHASES = 1 + 8 * DEPTH;
#ifndef DBG_LASTL
#define DBG_LASTL (DEPTH - 1)
#endif
#ifndef DBG_CTXUPD
#define DBG_CTXUPD DEPTH
#endif
constexpr int CTXUPD = DBG_CTXUPD;
constexpr int LASTL = DBG_LASTL;

constexpr size_t MiB = 1u << 20;
constexpr size_t WS_CTL = 0, CTL_ZERO_BYTES = 1 * MiB;
constexpr size_t WS_MOD = 1 * MiB;
constexpr size_t WS_GATES = 2 * MiB;
constexpr size_t WS_W_MIN = 8 * MiB;
constexpr size_t WS_W_MOUT = 58 * MiB;
constexpr size_t WS_W_AIN = 74 * MiB;
constexpr size_t WS_W_AOUT = 122 * MiB;
constexpr size_t WS_W_GU = 138 * MiB;
constexpr size_t WS_W_DN = 314 * MiB;
constexpr size_t WS_X = 402 * MiB;
constexpr size_t WS_HN = 538 * MiB;
constexpr size_t WS_OB = 606 * MiB;
constexpr size_t WS_PROJ = 674 * MiB;
constexpr size_t WS_HID = 887 * MiB;
constexpr size_t WS_HF = WS_HID, WS_HB = WS_HID + 136 * MiB;
constexpr size_t WS_SLAB = 1160 * MiB;
constexpr int KSPLIT = 4;
constexpr size_t WS_END = 1192 * MiB;
static_assert(WS_W_MIN + (size_t)2 * MIN_PAD * DM * 2 <= WS_W_MOUT && WS_W_AIN + (size_t)2 * AIN * DM * 2 <= WS_W_AOUT && WS_W_GU + (size_t)4 * NGU * DM * 2 <= WS_W_DN && WS_W_DN + (size_t)4 * DM * FFH * 2 <= WS_X, "ws map (weights)");
static_assert(WS_X + (size_t)MT * DM * 4 <= WS_HN && WS_HN + (size_t)MT * DM * 2 <= WS_OB && WS_OB + (size_t)MT * DM * 2 <= WS_PROJ && WS_PROJ + (size_t)MT * LDP * 2 <= WS_HID && WS_HB + (size_t)MT * DM * 4 <= WS_SLAB && WS_HID + (size_t)MT * FFH * 2 <= WS_SLAB && WS_SLAB + (size_t)KSPLIT * MC * DM * 4 <= WS_END, "ws map (activations)");
constexpr int CW_Q0 = 64;
constexpr int CW_BAR = 4096;
constexpr int CW_XTMO = 32;
constexpr size_t WS_XBUF = 5 * MiB;

constexpr int RING_BYTES = 147456;
constexpr int MISC_OFF = RING_BYTES;
constexpr int LDS_BYTES = RING_BYTES + 256;

#define GAS __attribute__((address_space(1)))
#define CAS __attribute__((address_space(4)))
#define LAS __attribute__((address_space(3)))
typedef unsigned short bf16;
typedef unsigned v4u __attribute__((ext_vector_type(4)));
typedef unsigned v2u __attribute__((ext_vector_type(2)));
typedef float f32x4 __attribute__((ext_vector_type(4)));
typedef float f32x16 __attribute__((ext_vector_type(16)));
typedef short bf16x8 __attribute__((ext_vector_type(8)));
typedef short s16x4 __attribute__((ext_vector_type(4)));
#define LDS_WAIT() asm volatile("s_waitcnt lgkmcnt(0)" ::: "memory")
#define VM_WAIT() asm volatile("s_waitcnt vmcnt(0)" ::: "memory")
__device__ __forceinline__ unsigned pk2(float lo, float hi) { return cvt_pk_bf16_hw(lo, hi); }
__device__ __forceinline__ unsigned f2bf(float f) { return cvt_pk_bf16_hw(f, f) & 0xffffu; }
__device__ __forceinline__ float bf_lo(unsigned w) { return __builtin_bit_cast(float, w << 16); }
__device__ __forceinline__ float bf_hi(unsigned w) { return __builtin_bit_cast(float, w & 0xffff0000u); }
__device__ __forceinline__ int opaque(int v) { asm volatile("" : "+v"(v)); return v; }
__device__ __forceinline__ float wave_sum(float v) {
#pragma unroll
    for (int o = 1; o < 64; o <<= 1) v += __shfl_xor(v, o);
    return v;
}

#define XB_TMO      128
#define XB_XCNT(j)  (256  + 64 * (j))
#define XB_XSUB(j)  (1280 + 64 * (j))
#define XB_XGEN(j)  (2304 + 64 * (j))
#define XB_TOP      3328
#define XB_TOPGEN   3392
#define XCD_BAR_WORDS 3456
#define XB_SPIN_CAP (1u << 18)

__device__ __forceinline__ unsigned xb_ld(unsigned* p)              { return __hip_atomic_load(p, __ATOMIC_RELAXED, __HIP_MEMORY_SCOPE_AGENT); }
__device__ __forceinline__ unsigned xb_add(unsigned* p, unsigned v) { return __hip_atomic_fetch_add(p, v, __ATOMIC_RELAXED, __HIP_MEMORY_SCOPE_AGENT); }
__device__ __forceinline__ unsigned xb_xcc_id() { return (unsigned)__builtin_amdgcn_s_getreg((3 << 11) | 20) & 0xFu; }
#define XB_SPIN(cond, bar) do { unsigned _sp = 0; while (cond) { __builtin_amdgcn_s_sleep(1); \
    if ((++_sp & 255u) == 0u) { if (xb_ld(&(bar)[XB_TMO])) break; if (_sp > XB_SPIN_CAP) { atomicAdd(&(bar)[XB_TMO], 1u); break; } } } } while (0)

struct XcdBarrier {
    unsigned* bar; unsigned x; int wave;
    volatile LAS unsigned* st;
};

__device__ __forceinline__ XcdBarrier xcd_barrier_post(unsigned* bar, volatile LAS unsigned* st, int wave) {
    XcdBarrier b; b.bar = bar; b.x = xb_xcc_id(); b.st = st; b.wave = wave;
    if (wave == 0 && lane_id() == 0) (void)xb_add(&bar[XB_XCNT(b.x)], 1u);
    return b;
}
__device__ __forceinline__ void xcd_barrier_complete(unsigned* bar, unsigned x, unsigned& nloc, unsigned& nx) {
    const unsigned G = gridDim.x * gridDim.y * gridDim.z;
    unsigned sum, cnt, mine, sp = 0u;
    for (;;) {
        sum = 0u; cnt = 0u; mine = 0u;
#pragma unroll
        for (unsigned j = 0; j < 16; ++j) { const unsigned c = xb_ld(&bar[XB_XCNT(j)]); sum += c; cnt += (c > 0u) ? 1u : 0u; mine = (j == x) ? c : mine; }
        if (sum == G) break;
        __builtin_amdgcn_s_sleep(1);
        if ((++sp & 255u) == 0u) { if (xb_ld(&bar[XB_TMO])) break; if (sp > XB_SPIN_CAP) { atomicAdd(&bar[XB_TMO], 1u); break; } }
    }
    nloc = mine > 0u ? mine : 1u; nx = cnt > 0u ? cnt : 1u;
}

__device__ __forceinline__ void xcd_barrier(const XcdBarrier& b) {
    asm volatile("s_waitcnt vmcnt(0)" ::: "memory");
    __syncthreads();
    if (b.wave == 0 && lane_id() == 0) {
        unsigned* bar = b.bar;
        __builtin_amdgcn_s_waitcnt(0);
        unsigned nloc = b.st[0], nx = b.st[1];
        if (nloc == 0u) { xcd_barrier_complete(bar, b.x, nloc, nx); b.st[0] = nloc; b.st[1] = nx; }
        const unsigned old = xb_add(&bar[XB_XSUB(b.x)], 1u);
        const unsigned gen = old / nloc;
        if (old + 1u == (gen + 1u) * nloc) {
            __builtin_amdgcn_fence(__ATOMIC_RELEASE, "agent");
            asm volatile("s_waitcnt vmcnt(0)" ::: "memory");
            const unsigned og = xb_add(&bar[XB_TOP], 1u);
            const unsigned tg = og / nx;
            if (og + 1u == (tg + 1u) * nx) xb_add(&bar[XB_TOPGEN], 1u);
            else XB_SPIN(xb_ld(&bar[XB_TOPGEN]) == tg, bar);
            __builtin_amdgcn_fence(__ATOMIC_ACQUIRE, "agent");
            xb_add(&bar[XB_XGEN(b.x)], 1u);
            asm volatile("s_waitcnt vmcnt(0)" ::: "memory");
        } else {
            XB_SPIN(xb_ld(&bar[XB_XGEN(b.x)]) == gen, bar);
            __builtin_amdgcn_fence(__ATOMIC_ACQUIRE, "agent");
            asm volatile("s_waitcnt vmcnt(0)" ::: "memory");
        }
    }
    __syncthreads();
}

struct Args { const float* in[22]; float* out; unsigned char* ws; int ph_lo, ph_hi; };
struct Frame {
    LAS unsigned char* lds;
    volatile LAS unsigned* MISC;
    int wave, vcu, G;
};
enum { IN_X = 0, IN_C, IN_CTX, IN_CCTX, IN_ADAW, IN_ADAB, IN_NORMG, IN_MWIN, IN_MGB, IN_MHG, IN_MWOUT, IN_AWIN, IN_AWOUT, IN_AQG, IN_AKG, IN_LQ1, IN_LK1, IN_LQ2, IN_LK2, IN_SUBG, IN_WGU, IN_WDN };

__device__ __forceinline__ void p0_transpose_item(const float* W, int K, int N, bf16* WT, int mode, LAS float* scr, int item, int lane) {
    const int nblk = N / 32, kb = item / nblk, nb = item % nblk, k0 = 64 * kb, n0 = 32 * nb;
    int r0 = n0, rstep = 1;
    if (mode == 2 && n0 < 2 * DM) { const int head = n0 >> 7, d0 = n0 & 127; r0 = head * 128 + (d0 >> 6) * 64 + ((d0 >> 5) & 1); rstep = 2; }
    if (mode == 1) { const int up = n0 >= FFH ? 1 : 0, j = n0 - up * FFH; r0 = (j >> 7) * 256 + up * 128 + (j & 127); }
    { const int r8 = lane >> 3, c4 = lane & 7;
      f32x4 t[8];
#pragma unroll
      for (int i = 0; i < 8; ++i) t[i] = *(const GAS f32x4*)(W + (size_t)(k0 + 8 * i + r8) * N + n0 + 4 * c4);
#pragma unroll
      for (int i = 0; i < 8; ++i) { LAS float* d = scr + (8 * i + r8) * 33 + 4 * c4; d[0] = t[i].x; d[1] = t[i].y; d[2] = t[i].z; d[3] = t[i].w; } }
    LDS_WAIT(); asm volatile("" ::: "memory");
    const int c = lane & 7;
#pragma unroll
    for (int j = 0; j < 4; ++j) { const int n = (lane >> 3) + 8 * j; const LAS float* s = scr + (8 * c) * 33 + n;
        v4u o; o.x = pk2(s[0 * 33], s[1 * 33]); o.y = pk2(s[2 * 33], s[3 * 33]); o.z = pk2(s[4 * 33], s[5 * 33]); o.w = pk2(s[6 * 33], s[7 * 33]);
        *(GAS v4u*)(WT + (size_t)(r0 + n * rstep) * K + k0 + 8 * c) = o; }
    LDS_WAIT(); asm volatile("" ::: "memory");
}
constexpr int I_MIN = (DM / 64) * (MIN_REAL / 32), I_SQ = (DM / 64) * (DM / 32), I_AIN = (DM / 64) * (AIN / 32), I_GU = (DM / 64) * (NGU / 32), I_DN = (FFH / 64) * (DM / 32);
__device__ __forceinline__ int layer_items(int L) { return ((L & 1) ? I_AIN : I_MIN) + I_SQ + I_GU + I_DN; }
__device__ __forceinline__ void convert_item_layer(const Args& A, int L, int idx, LAS float* scr, int lane) {
    const bool ml = (L & 1) == 0; const int j = L >> 1, iin = ml ? I_MIN : I_AIN;
    if (idx < iin) { if (ml) p0_transpose_item(A.in[IN_MWIN] + (size_t)j * DM * MIN_REAL, DM, MIN_REAL, (bf16*)(A.ws + WS_W_MIN) + (size_t)j * MIN_PAD * DM, 0, scr, idx, lane);
                     else p0_transpose_item(A.in[IN_AWIN] + (size_t)j * DM * AIN, DM, AIN, (bf16*)(A.ws + WS_W_AIN) + (size_t)j * AIN * DM, 2, scr, idx, lane); return; }
    idx -= iin;
    if (idx < I_SQ) { p0_transpose_item((ml ? A.in[IN_MWOUT] : A.in[IN_AWOUT]) + (size_t)j * DM * DM, DM, DM, (bf16*)(A.ws + (ml ? WS_W_MOUT : WS_W_AOUT)) + (size_t)j * DM * DM, 0, scr, idx, lane); return; }
    idx -= I_SQ;
    if (idx < I_GU) { p0_transpose_item(A.in[IN_WGU] + (size_t)L * DM * NGU, DM, NGU, (bf16*)(A.ws + WS_W_GU) + (size_t)L * NGU * DM, 1, scr, idx, lane); return; }
    idx -= I_GU;
    p0_transpose_item(A.in[IN_WDN] + (size_t)L * FFH * DM, FFH, DM, (bf16*)(A.ws + WS_W_DN) + (size_t)L * DM * FFH, 0, scr, idx, lane);
}
__device__ __forceinline__ void help_convert(Frame& F, const Args& A, int L, int budget) {
    const int lane = lane_id();
    unsigned* qh = (unsigned*)(A.ws + WS_CTL) + CW_Q0 + 64 * L;
    const int nit = layer_items(L), nch = (nit + 15) >> 4;
    LAS float* scr = (LAS float*)(F.lds + F.wave * 16384);
    for (int k = 0; k < budget; ++k) {
        if (F.wave == 0 && lane == 0) F.MISC[16 + (k & 1)] = __hip_atomic_fetch_add(qh, 1u, __ATOMIC_RELAXED, __HIP_MEMORY_SCOPE_AGENT);
        __syncthreads();
        const int ch = (int)F.MISC[16 + (k & 1)];
        if (ch >= nch) break;
#pragma unroll
        for (int i = 0; i < 2; ++i) { const int it = ch * 16 + i * 8 + F.wave; if (it < nit) convert_item_layer(A, L, it, scr, lane); }
    }
}
__device__ __forceinline__ float silu_f(float x) { return x / (1.0f + __expf(-x)); }
__device__ __forceinline__ void p0_prologue(Frame& F, const Args& A_, int conv_layers) {
    const Args& A = A_;
    const int lane_l = lane_id(), tid_l = F.wave * 64 + lane_l; (void)tid_l; (void)lane_l;
    float* MOD = (float*)(A.ws + WS_MOD);
    if ((int)blockIdx.x < 192) {
        LAS float* sc = (LAS float*)F.lds;
        LAS float* part = (LAS float*)(F.lds + 40960);
        for (int i = tid_l; i < 5 * DM; i += NWAVES * 64) { const float v = i < 4 * DM ? A.in[IN_C][i] : A.in[IN_CCTX][i - 4 * DM]; sc[i] = silu_f(v); }
        __syncthreads();
        for (int it = blockIdx.x; it < 192; it += F.G) {
            const int l = it / 48, strip = it % 48;
            const float* W = A.in[IN_ADAW] + (size_t)l * DM * 12288 + strip * 256 + lane_l * 4;
            f32x4 acc[5];
#pragma unroll
            for (int r = 0; r < 5; ++r) acc[r] = (f32x4){0.f, 0.f, 0.f, 0.f};
            const int kbeg = F.wave * 256;
#pragma unroll 2
            for (int k = kbeg; k < kbeg + 256; k += 4) {
                const f32x4 w0 = *(const GAS f32x4*)(W + (size_t)(k + 0) * 12288), w1 = *(const GAS f32x4*)(W + (size_t)(k + 1) * 12288);
                const f32x4 w2 = *(const GAS f32x4*)(W + (size_t)(k + 2) * 12288), w3 = *(const GAS f32x4*)(W + (size_t)(k + 3) * 12288);
#pragma unroll
                for (int r = 0; r < 5; ++r) { const f32x4 s = *(const LAS f32x4*)(sc + r * DM + k); acc[r] += w0 * s.x + w1 * s.y + w2 * s.z + w3 * s.w; }
            }
#pragma unroll
            for (int r = 0; r < 5; ++r) *(LAS f32x4*)(part + ((F.wave * 5 + r) * 64 + lane_l) * 4) = acc[r];
            __syncthreads();
            for (int o = tid_l; o < 5 * 256; o += NWAVES * 64) { const int r = o >> 8, c = o & 255; float s = A.in[IN_ADAB][l * 12288 + strip * 256 + c];
#pragma unroll
                for (int w = 0; w < 8; ++w) s += part[(w * 5 + r) * 256 + c];
                MOD[(size_t)(l * 5 + r) * 12288 + strip * 256 + c] = s; }
            __syncthreads();
        }
    }
    __syncthreads();
    LAS float* scr = (LAS float*)(F.lds + F.wave * 16384);
    const int gw = F.vcu * NWAVES + F.wave, NGW = F.G * NWAVES;
    for (int L = 0; L < conv_layers; ++L) help_convert(F, A, L, 1 << 30);
}

template <bool FIRST>
__device__ __forceinline__ void norm_phase(Frame& F, const Args& A_, int layer, int which, int row_begin, int mrows, const float* slab_gate) {
    const Args& A = A_;
    const int lane_l = lane_id(), tid_l = F.wave * 64 + lane_l; (void)tid_l; (void)lane_l;
    const int gw = F.vcu * NWAVES + F.wave, NGW = F.G * NWAVES;
    unsigned short* X = (unsigned short*)(A.ws + WS_X); bf16* HN = (bf16*)(A.ws + WS_HN);
    const float* gain = A.in[IN_NORMG] + (size_t)(layer * 2 + which) * DM;
    const float* MODL = (const float*)(A.ws + WS_MOD) + (size_t)layer * 5 * 12288 + (which ? 3 * DM : 0);
    f32x4 GG[8], SH[8], vn[8]; int cur_m = -1;
#define VIDX(j_) (2 * lane_l + 128 * ((j_) >> 1) + ((j_) & 1))
#define NORM_LOAD(dst, r) do { if (FIRST) { const GAS f32x4* xr_ = (const GAS f32x4*)((r) < ML ? A.in[IN_X] + (size_t)(r) * DM : A.in[IN_CTX] + (size_t)((r) - ML) * DM); \
            _Pragma("unroll") for (int j_ = 0; j_ < 8; ++j_) dst[j_] = xr_[VIDX(j_)]; } \
        else { const GAS v4u* xr_ = (const GAS v4u*)(X + (size_t)(r) * DM) + lane_l; \
            _Pragma("unroll") for (int c_ = 0; c_ < 4; ++c_) { const v4u w_ = xr_[64 * c_]; dst[2 * c_] = (f32x4){h_lo(w_.x), h_hi(w_.x), h_lo(w_.y), h_hi(w_.y)}; dst[2 * c_ + 1] = (f32x4){h_lo(w_.z), h_hi(w_.z), h_lo(w_.w), h_hi(w_.w)}; } } } while (0)
#define NORM_STORE_X(r, src) do { GAS v4u* xo_ = (GAS v4u*)(X + (size_t)(r) * DM) + lane_l; \
        _Pragma("unroll") for (int c_ = 0; c_ < 4; ++c_) { v4u w_; w_.x = pkh2(src[2 * c_].x, src[2 * c_].y); w_.y = pkh2(src[2 * c_].z, src[2 * c_].w); w_.z = pkh2(src[2 * c_ + 1].x, src[2 * c_ + 1].y); w_.w = pkh2(src[2 * c_ + 1].z, src[2 * c_ + 1].w); xo_[64 * c_] = w_; } } while (0)
    int row = row_begin + gw;
    if (row < mrows) NORM_LOAD(vn, row);
    while (row < mrows) {
        f32x4 v[8]; float s = 0.f;
#pragma unroll
        for (int j = 0; j < 8; ++j) v[j] = vn[j];
        const int nrow = row + NGW;
        if (nrow < mrows) NORM_LOAD(vn, nrow);
        const int mrow = row < ML ? (row >> 12) : 4;
        if (mrow != cur_m) { cur_m = mrow; const float* md = MODL + (size_t)mrow * 12288;
#pragma unroll
            for (int j = 0; j < 8; ++j) { const f32x4 g = *((const GAS f32x4*)gain + VIDX(j)), sc = *((const GAS f32x4*)(md + DM) + VIDX(j));
                GG[j] = g * (sc + 1.0f); SH[j] = *((const GAS f32x4*)md + VIDX(j)); } }
        if (!FIRST && slab_gate != nullptr && row >= ML) {
            const GAS f32x4* sl = (const GAS f32x4*)((const float*)(A.ws + WS_SLAB) + (size_t)(row - ML) * DM);
#pragma unroll
            for (int j = 0; j < 8; ++j) { f32x4 p = sl[VIDX(j)];
#pragma unroll
                for (int k = 1; k < KSPLIT; ++k) p += sl[VIDX(j) + (size_t)k * MC * DM / 4];
                v[j] += *((const GAS f32x4*)slab_gate + VIDX(j)) * p; }
            NORM_STORE_X(row, v);
        }
#pragma unroll
        for (int j = 0; j < 8; ++j) s += (v[j].x * v[j].x + v[j].y * v[j].y) + (v[j].z * v[j].z + v[j].w * v[j].w);
        const float rs = 1.0f / sqrtf(wave_sum(s) * (1.0f / DM) + EPS);
        if (FIRST) NORM_STORE_X(row, v);
        GAS v4u* o16 = (GAS v4u*)(HN + (size_t)row * DM) + lane_l;
#pragma unroll
        for (int c = 0; c < 4; ++c) { const f32x4 y0 = (v[2 * c] * rs) * GG[2 * c] + SH[2 * c], y1 = (v[2 * c + 1] * rs) * GG[2 * c + 1] + SH[2 * c + 1];
            v4u w; w.x = pk2(y0.x, y0.y); w.y = pk2(y0.z, y0.w); w.z = pk2(y1.x, y1.y); w.w = pk2(y1.z, y1.w); o16[64 * c] = w; }
        row = nrow;
    }
#undef VIDX
#undef NORM_LOAD
#undef NORM_STORE_X
}

constexpr int SC_G = 0, SC_PM = 17408, SC_BC = 34816, SC_Q = 52224, SC_K = 69632, SC_V = 87040, SC_VW = 97280, SC_C = 107520, SC_SW = 129280, SC_END = 138496;
constexpr int QSTR = 272, VSTR = 160, SWSTR = 144, CTSTR = 272;
static_assert(SC_END <= RING_BYTES, "scan LDS map");
__device__ __forceinline__ int scan_row(int b, int dir, int c, int t) {
    if (c < 4) { const int p = c * 64 + t; return ML + b * CTXL + (dir ? (CTXL - 1 - p) : p); }
    const int p = (c - 4) * 64 + t; return b * SEQ + (dir ? (SEQ - 1 - p) : p);
}
__device__ __forceinline__ bf16x8 tr_pair(const LAS unsigned char* p, int stride4) {
    const s16x4 a = __builtin_amdgcn_ds_read_tr16_b64_v4i16((LAS s16x4*)p), b = __builtin_amdgcn_ds_read_tr16_b64_v4i16((LAS s16x4*)(p + stride4));
    return (bf16x8){a[0], a[1], a[2], a[3], b[0], b[1], b[2], b[3]};
}
#define LDS_BARRIER() do { asm volatile("s_waitcnt lgkmcnt(0)" ::: "memory"); __builtin_amdgcn_s_barrier(); asm volatile("" ::: "memory"); } while (0)
__device__ __forceinline__ void mlstm_scan_phase(Frame& F, const Args& A_) {
    const Args& A = A_;
    const bf16* PROJ = (const bf16*)(A.ws + WS_PROJ); const float* GATES = (const float*)(A.ws + WS_GATES);
    LAS unsigned char* lds = F.lds;
    LAS float* Gs = (LAS float*)(lds + SC_G); LAS float* PMs = (LAS float*)(lds + SC_PM); LAS float* BCs = (LAS float*)(lds + SC_BC);
    const int lane = lane_id(), wave = F.wave, tid = wave * 64 + lane, l15 = lane & 15, g4 = lane >> 4, tq = (lane >> 2) & 3, tp = lane & 3;
    const int sr = tid >> 3, sp = tid & 7;
    for (int u = blockIdx.x; u < 256; u += F.G) {
        const int b = u >> 6, h = (u >> 3) & 7, dir = (u >> 2) & 1, js = u & 3;
        _Float16* HO = (_Float16*)(A.ws + (dir ? WS_HB : WS_HF));
        for (int c = wave; c < 68; c += 8) {
            const int row = scan_row(b, dir, c, lane);
            const float iv = GATES[(size_t)row * 32 + dir * 16 + h], lf = GATES[(size_t)row * 32 + dir * 16 + 8 + h];
            float bs = lf;
#pragma unroll
            for (int d = 1; d < 64; d <<= 1) { const float t = __shfl_up(bs, d); if (lane >= d) bs += t; }
            const float g = iv - bs; float pm = g;
#pragma unroll
            for (int d = 1; d < 64; d <<= 1) { const float t = __shfl_up(pm, d); if (lane >= d) pm = fmaxf(pm, t); }
            Gs[c * 64 + lane] = g; PMs[c * 64 + lane] = pm; BCs[c * 64 + lane] = bs;
        }
        for (int i = tid; i < (80 * CTSTR) / 16; i += NWAVES * 64) *(LAS v4u*)(lds + SC_C + i * 16) = (v4u){0u, 0u, 0u, 0u};
        if (sp == 0) *(LAS v4u*)(lds + SC_V + sr * VSTR + 128) = (v4u){0x3F80u, 0u, 0u, 0u};
        if (sp == 1) { *(LAS v4u*)(lds + SC_V + sr * VSTR + 144) = (v4u){0u, 0u, 0u, 0u}; *(LAS v4u*)(lds + SC_VW + sr * VSTR + 144) = (v4u){0u, 0u, 0u, 0u}; }
        f32x4 Cacc[5];
#pragma unroll
        for (int e = 0; e < 5; ++e) Cacc[e] = (f32x4){0.f, 0.f, 0.f, 0.f};
        float m = 0.f;
        bf16x8 rq0, rq1, rk0, rk1, rv;
#define SCAN_LOAD(cc) do { const bf16* pr = PROJ + (size_t)scan_row(b, dir, (cc), sr) * LDP; \
            rq0 = *(const GAS bf16x8*)(pr + h * 128 + sp * 16); rq1 = *(const GAS bf16x8*)(pr + h * 128 + sp * 16 + 8); \
            rk0 = *(const GAS bf16x8*)(pr + 1024 + h * 128 + sp * 16); rk1 = *(const GAS bf16x8*)(pr + 1024 + h * 128 + sp * 16 + 8); \
            rv = *(const GAS bf16x8*)(pr + 2048 + h * 256 + js * 64 + sp * 8); } while (0)
        SCAN_LOAD(0);
        __syncthreads();
        float hv[8];
#pragma unroll
        for (int i = 0; i < 8; ++i) hv[i] = 0.f;
#define SCAN_STORE_H(cc) do { _Pragma("unroll") for (int r_ = 0; r_ < 4; ++r_) { _Float16* hp_ = HO + (size_t)scan_row(b, dir, (cc), 16 * (wave & 3) + 4 * g4 + r_) * DM + h * 256 + js * 64 + l15; \
            hp_[16 * (2 * (wave >> 2))] = (_Float16)__builtin_amdgcn_fmed3f(hv[2 * r_], -65000.0f, 65000.0f); hp_[16 * (2 * (wave >> 2) + 1)] = (_Float16)__builtin_amdgcn_fmed3f(hv[2 * r_ + 1], -65000.0f, 65000.0f); } } while (0)
        for (int c = 0; c < 68; ++c) {
            *(LAS bf16x8*)(lds + SC_Q + sr * QSTR + sp * 32) = rq0; *(LAS bf16x8*)(lds + SC_Q + sr * QSTR + sp * 32 + 16) = rq1;
            *(LAS bf16x8*)(lds + SC_K + sr * QSTR + sp * 32) = rk0; *(LAS bf16x8*)(lds + SC_K + sr * QSTR + sp * 32 + 16) = rk1;
            *(LAS bf16x8*)(lds + SC_V + sr * VSTR + sp * 16) = rv;
            { const float w63 = __expf(Gs[c * 64 + sr] - PMs[c * 64 + 63]);
              const v4u vr = __builtin_bit_cast(v4u, rv); v4u vw;
              vw.x = pk2(bf_lo(vr.x) * w63, bf_hi(vr.x) * w63); vw.y = pk2(bf_lo(vr.y) * w63, bf_hi(vr.y) * w63);
              vw.z = pk2(bf_lo(vr.z) * w63, bf_hi(vr.z) * w63); vw.w = pk2(bf_lo(vr.w) * w63, bf_hi(vr.w) * w63);
              *(LAS v4u*)(lds + SC_VW + sr * VSTR + sp * 16) = vw;
              if (sp == 0) *(LAS v4u*)(lds + SC_VW + sr * VSTR + 128) = (v4u){f2bf(w63), 0u, 0u, 0u}; }
            LDS_BARRIER();
            if (c > 0) SCAN_STORE_H(c - 1);
            if (c + 1 < 68) SCAN_LOAD(c + 1);
            const int tt = wave & 3, ch = wave >> 2;
            bf16x8 aq[4], bk[2][4], bc[3][4];
#pragma unroll
            for (int ks = 0; ks < 4; ++ks) aq[ks] = *(const LAS bf16x8*)(lds + SC_Q + (16 * tt + l15) * QSTR + ks * 64 + g4 * 16);
#pragma unroll
            for (int i = 0; i < 2; ++i)
#pragma unroll
                for (int ks = 0; ks < 4; ++ks) bk[i][ks] = *(const LAS bf16x8*)(lds + SC_K + (16 * (2 * ch + i) + l15) * QSTR + ks * 64 + g4 * 16);
#pragma unroll
            for (int i = 0; i < 3; ++i) { const int et = i < 2 ? 2 * ch + i : 4;
#pragma unroll
                for (int ks = 0; ks < 4; ++ks) bc[i][ks] = *(const LAS bf16x8*)(lds + SC_C + (16 * et + l15) * CTSTR + ks * 64 + g4 * 16); }
            float gsv[2], pmv[4];
#pragma unroll
            for (int i = 0; i < 2; ++i) gsv[i] = Gs[c * 64 + 16 * (2 * ch + i) + l15];
#pragma unroll
            for (int r = 0; r < 4; ++r) pmv[r] = PMs[c * 64 + 16 * tt + 4 * g4 + r];
            f32x4 sacc[2], cacc[3];
#pragma unroll
            for (int i = 0; i < 2; ++i) { sacc[i] = (f32x4){0.f, 0.f, 0.f, 0.f};
#pragma unroll
                for (int ks = 0; ks < 4; ++ks) sacc[i] = __builtin_amdgcn_mfma_f32_16x16x32_bf16(aq[ks], bk[i][ks], sacc[i], 0, 0, 0); }
#pragma unroll
            for (int i = 0; i < 3; ++i) { cacc[i] = (f32x4){0.f, 0.f, 0.f, 0.f};
#pragma unroll
                for (int ks = 0; ks < 4; ++ks) cacc[i] = __builtin_amdgcn_mfma_f32_16x16x32_bf16(aq[ks], bc[i][ks], cacc[i], 0, 0, 0); }
#pragma unroll
            for (int i = 0; i < 2; ++i) { const int s = 16 * (2 * ch + i) + l15; float sw[4];
#pragma unroll
                for (int r = 0; r < 4; ++r) { const int t = 16 * tt + 4 * g4 + r; const float e = __expf(fminf(gsv[i] - pmv[r], 0.f)), mk = (s <= t) ? 1.0f : 0.0f; sw[r] = sacc[i][r] * e * mk; }
                v2u pk; pk.x = pk2(sw[0], sw[1]); pk.y = pk2(sw[2], sw[3]);
                *(LAS v2u*)(lds + SC_SW + s * SWSTR + (16 * tt + 4 * g4) * 2) = pk; }
            LDS_BARRIER();
            bf16x8 as2[2], bv[3][2], ak[2], bw[5][2];
#pragma unroll
            for (int k2 = 0; k2 < 2; ++k2) as2[k2] = tr_pair(lds + SC_SW + (32 * k2 + 8 * g4 + tq) * SWSTR + (16 * tt + 4 * tp) * 2, 4 * SWSTR);
#pragma unroll
            for (int i = 0; i < 3; ++i) { const int et = i < 2 ? 2 * ch + i : 4;
#pragma unroll
                for (int k2 = 0; k2 < 2; ++k2) bv[i][k2] = tr_pair(lds + SC_V + (32 * k2 + 8 * g4 + tq) * VSTR + (16 * et + 4 * tp) * 2, 4 * VSTR); }
#pragma unroll
            for (int k2 = 0; k2 < 2; ++k2) ak[k2] = tr_pair(lds + SC_K + (32 * k2 + 8 * g4 + tq) * QSTR + (16 * wave + 4 * tp) * 2, 4 * QSTR);
#pragma unroll
            for (int et = 0; et < 5; ++et)
#pragma unroll
                for (int k2 = 0; k2 < 2; ++k2) bw[et][k2] = tr_pair(lds + SC_VW + (32 * k2 + 8 * g4 + tq) * VSTR + (16 * et + 4 * tp) * 2, 4 * VSTR);
            float bcv[4]; const float pm63 = PMs[c * 64 + 63], b63 = BCs[c * 64 + 63];
#pragma unroll
            for (int r = 0; r < 4; ++r) bcv[r] = BCs[c * 64 + 16 * tt + 4 * g4 + r];
            f32x4 nacc[3], dC[5];
#pragma unroll
            for (int i = 0; i < 3; ++i) { nacc[i] = (f32x4){0.f, 0.f, 0.f, 0.f};
#pragma unroll
                for (int k2 = 0; k2 < 2; ++k2) nacc[i] = __builtin_amdgcn_mfma_f32_16x16x32_bf16(as2[k2], bv[i][k2], nacc[i], 0, 0, 0); }
#pragma unroll
            for (int et = 0; et < 5; ++et) { dC[et] = (f32x4){0.f, 0.f, 0.f, 0.f};
#pragma unroll
                for (int k2 = 0; k2 < 2; ++k2) dC[et] = __builtin_amdgcn_mfma_f32_16x16x32_bf16(ak[k2], bw[et][k2], dC[et], 0, 0, 0); }
            float inv[4];
#pragma unroll
            for (int r = 0; r < 4; ++r) { const float pm = pmv[r], Mt = fmaxf(m, pm), wi = __expf(m - Mt), wl = __expf(pm - Mt);
#pragma unroll
                for (int i = 0; i < 3; ++i) nacc[i][r] = wi * cacc[i][r] + wl * nacc[i][r];
                const float den = __shfl(nacc[2][r], lane & 48);
                inv[r] = __builtin_amdgcn_rcpf(fmaxf(fabsf(den), __expf(-(bcv[r] + Mt)))); }
#pragma unroll
            for (int r = 0; r < 4; ++r) { hv[2 * r] = nacc[0][r] * inv[r]; hv[2 * r + 1] = nacc[1][r] * inv[r]; }
            { const float M63 = fmaxf(m, pm63), dec = __expf(m - M63), scal = __expf(pm63 - M63);
#pragma unroll
              for (int et = 0; et < 5; ++et) { Cacc[et] = Cacc[et] * dec + dC[et] * scal;
                  v2u pk; pk.x = pk2(Cacc[et][0], Cacc[et][1]); pk.y = pk2(Cacc[et][2], Cacc[et][3]);
                  *(LAS v2u*)(lds + SC_C + (16 * et + l15) * CTSTR + (16 * wave + 4 * g4) * 2) = pk; }
              m = b63 + M63; }
            LDS_BARRIER();
        }
        SCAN_STORE_H(67);
#undef SCAN_LOAD
#undef SCAN_STORE_H
    }
}
__device__ __forceinline__ void mlstm_finish_phase(Frame& F, const Args& A_, int j) {
    const Args& A = A_;
    const int lane_l = lane_id(), tid_l = F.wave * 64 + lane_l; (void)tid_l; (void)lane_l;
    const int gw = F.vcu * NWAVES + F.wave, NGW = F.G * NWAVES;
    const unsigned short* HF = (const unsigned short*)(A.ws + WS_HF); const unsigned short* HB = (const unsigned short*)(A.ws + WS_HB);
    const bf16* PROJ = (const bf16*)(A.ws + WS_PROJ); bf16* OB = (bf16*)(A.ws + WS_OB);
    const float* hg = A.in[IN_MHG] + (size_t)j * DM;
    for (int row = gw; row < MT; row += NGW) {
        const GAS v4u* a = (const GAS v4u*)(HF + (size_t)row * DM) + lane_l; const GAS v4u* bq = (const GAS v4u*)(HB + (size_t)row * DM) + lane_l;
        const GAS v4u* og = (const GAS v4u*)(PROJ + (size_t)row * LDP + 4096) + lane_l;
        GAS v4u* o16 = (GAS v4u*)(OB + (size_t)row * DM) + lane_l;
#pragma unroll
        for (int st = 0; st < 4; ++st) {
            const v4u wa = a[64 * st], wb = bq[64 * st], ow = og[64 * st];
            float v[8] = {h_lo(wa.x) + h_lo(wb.x), h_hi(wa.x) + h_hi(wb.x), h_lo(wa.y) + h_lo(wb.y), h_hi(wa.y) + h_hi(wb.y), h_lo(wa.z) + h_lo(wb.z), h_hi(wa.z) + h_hi(wb.z), h_lo(wa.w) + h_lo(wb.w), h_hi(wa.w) + h_hi(wb.w)};
            float ss = 0.f;
#pragma unroll
            for (int i = 0; i < 8; ++i) ss += v[i] * v[i];
            ss += __shfl_xor(ss, 1); ss += __shfl_xor(ss, 2); ss += __shfl_xor(ss, 4); ss += __shfl_xor(ss, 8); ss += __shfl_xor(ss, 16);
            const float rs = 1.0f / sqrtf(ss * (1.0f / DVH) + EPS);
            const f32x4 g0 = *((const GAS f32x4*)hg + 2 * lane_l + 128 * st), g1 = *((const GAS f32x4*)hg + 2 * lane_l + 128 * st + 1);
            const float o[8] = {bf_lo(ow.x), bf_hi(ow.x), bf_lo(ow.y), bf_hi(ow.y), bf_lo(ow.z), bf_hi(ow.z), bf_lo(ow.w), bf_hi(ow.w)};
            float y[8];
#pragma unroll
            for (int i = 0; i < 8; ++i) y[i] = v[i] * rs * (i < 4 ? g0[i] : g1[i - 4]) * (1.0f / (1.0f + __expf(-o[i])));
            v4u w; w.x = pk2(y[0], y[1]); w.y = pk2(y[2], y[3]); w.z = pk2(y[4], y[5]); w.w = pk2(y[6], y[7]); o16[64 * st] = w;
        }
    }
}

constexpr float QSCALE = 0.08838834764831845f * 1.4426950408889634f;
__device__ __forceinline__ void qknorm_phase(Frame& F, const Args& A_, int j) {
    const Args& A = A_;
    const int lane_l = lane_id(), tid_l = F.wave * 64 + lane_l; (void)tid_l; (void)lane_l;
    const int gw = F.vcu * NWAVES + F.wave, NGW = F.G * NWAVES;
    bf16* PROJ = (bf16*)(A.ws + WS_PROJ);
    const float* qg = A.in[IN_AQG] + (size_t)j * 128; const float* kg = A.in[IN_AKG] + (size_t)j * 128;
    const int fgrp = lane_l & 7, half = (lane_l >> 3) & 1, hvsub = lane_l >> 4;
    float fr[4];
#pragma unroll
    for (int i = 0; i < 4; ++i) fr[i] = exp2f(-(float)(4 * fgrp + i) * (13.287712379549449f / 32.0f)) * 0.15915494309189535f;
    f32x4 gq1 = *(const f32x4*)(qg + half * 64 + 4 * fgrp), gq2 = *(const f32x4*)(qg + half * 64 + 32 + 4 * fgrp);
    f32x4 gk1 = *(const f32x4*)(kg + half * 64 + 4 * fgrp), gk2 = *(const f32x4*)(kg + half * 64 + 32 + 4 * fgrp);
    for (int row = gw; row < MT; row += NGW) {
        float cs[4], sn[4];
        if (row < ML) { const int s = row & (SEQ - 1); const float pos = (float)(half ? (s & 63) : (s >> 6));
#pragma unroll
            for (int i = 0; i < 4; ++i) { float rev = pos * fr[i]; rev -= rintf(rev); cs[i] = __builtin_amdgcn_cosf(rev); sn[i] = __builtin_amdgcn_sinf(rev); }
        } else {
#pragma unroll
            for (int i = 0; i < 4; ++i) { cs[i] = 1.f; sn[i] = 0.f; } }
        bf16* base = PROJ + (size_t)row * LDP + half * 64 + 4 * fgrp;
#pragma unroll
        for (int it = 0; it < 8; ++it) {
            const int hv = 4 * it + hvsub;
            GAS v2u* p1 = (GAS v2u*)(base + hv * 128); GAS v2u* p2 = (GAS v2u*)(base + hv * 128 + 32);
            const v2u a = *p1, c = *p2;
            float x1[4] = {bf_lo(a.x), bf_hi(a.x), bf_lo(a.y), bf_hi(a.y)}, x2[4] = {bf_lo(c.x), bf_hi(c.x), bf_lo(c.y), bf_hi(c.y)};
            float ss = 0.f;
#pragma unroll
            for (int i = 0; i < 4; ++i) ss += x1[i] * x1[i] + x2[i] * x2[i];
            ss += __shfl_xor(ss, 1); ss += __shfl_xor(ss, 2); ss += __shfl_xor(ss, 4); ss += __shfl_xor(ss, 8);
            const bool isq = hv < 16;
            const float rs = (1.0f / sqrtf(ss * (1.0f / 128.0f) + EPS)) * (isq ? QSCALE : 1.0f);
            const f32x4 g1 = isq ? gq1 : gk1, g2 = isq ? gq2 : gk2;
            float o1[4], o2[4];
#pragma unroll
            for (int i = 0; i < 4; ++i) { const float y1 = x1[i] * rs * g1[i], y2 = x2[i] * rs * g2[i]; o1[i] = y1 * cs[i] - y2 * sn[i]; o2[i] = y2 * cs[i] + y1 * sn[i]; }
            v2u w1, w2; w1.x = pk2(o1[0], o1[1]); w1.y = pk2(o1[2], o1[3]); w2.x = pk2(o2[0], o2[1]); w2.y = pk2(o2[2], o2[3]);
            *p1 = w1; *p2 = w2;
        }
    }
}
constexpr int AT_K = 0, AT_V = 65536, AT_SCR = 131072, AT_PAR = AT_SCR + 2048;
#define KSWZ(row, colB) ((row) * 256 + ((colB) ^ (((row) & 7) << 4)))
__device__ __forceinline__ int crow(int r, int hi) { return (r & 3) + 8 * (r >> 2) + 4 * hi; }
__device__ __forceinline__ int v_st8(int k, int c) { const int kk = (k & ~0xC) | ((k & 4) << 1) | ((k & 8) >> 1); return ((kk >> 3) * 8 + (c >> 5)) * 512 + ((kk & 7) * 32 + (c & 31)) * 2; }
__device__ __forceinline__ int v_rd_base(int lane) { return ((lane & 3) << 3) | (((lane >> 2) & 3) << 6) | (((lane >> 4) & 1) << 5) | (((lane >> 5) & 1) << 8); }
template <int D0> __device__ __forceinline__ void pv_one(f32x16& od, const LAS unsigned char* vb, bf16x8 pa0, bf16x8 pa1, bf16x8 pa2, bf16x8 pa3) {
#define TRR(ks, half) __builtin_amdgcn_ds_read_tr16_b64_v4i16((LAS s16x4*)(vb + D0 * 512 + (ks) * 8192 + (half) * 4096))
    const s16x4 l0 = TRR(0, 0), h0 = TRR(0, 1), l1 = TRR(1, 0), h1 = TRR(1, 1), l2 = TRR(2, 0), h2 = TRR(2, 1), l3 = TRR(3, 0), h3 = TRR(3, 1);
#undef TRR
#define PK(L, H) (bf16x8){L[0], L[1], L[2], L[3], H[0], H[1], H[2], H[3]}
    od = __builtin_amdgcn_mfma_f32_32x32x16_bf16(pa0, PK(l0, h0), od, 0, 0, 0);
    od = __builtin_amdgcn_mfma_f32_32x32x16_bf16(pa1, PK(l1, h1), od, 0, 0, 0);
    od = __builtin_amdgcn_mfma_f32_32x32x16_bf16(pa2, PK(l2, h2), od, 0, 0, 0);
    od = __builtin_amdgcn_mfma_f32_32x32x16_bf16(pa3, PK(l3, h3), od, 0, 0, 0);
#undef PK
}
__device__ __forceinline__ void glds16_asm(const void* gsrc, unsigned lds_dst) {
    unsigned keep;
    asm volatile("s_mov_b32 %0, m0\n\ts_mov_b32 m0, %2\n\ts_nop 0\n\tglobal_load_lds_dwordx4 %1, off\n\ts_mov_b32 m0, %0" : "=&s"(keep) : "v"(gsrc), "s"(lds_dst) : "memory");
}
__device__ __forceinline__ unsigned cvtpk(float lo, float hi) { return cvt_pk_bf16_hw(lo, hi); }
__device__ __forceinline__ void attn_phase(Frame& F, const Args& A_, int layer, int j, bool upd) {
    const Args& A = A_;
    LAS unsigned char* lds = F.lds;
    const bf16* PROJ = (const bf16*)(A.ws + WS_PROJ); bf16* OB = (bf16*)(A.ws + WS_OB);
    const int lane = lane_id(), wave = F.wave, tid = wave * 64 + lane, r32 = lane & 31, hi = lane >> 5, g = wave & 3, mp = wave >> 2;
    LAS float* par = (LAS float*)(lds + AT_PAR);
    if (wave == 0) {
        const float* lq1 = A.in[IN_LQ1] + j * 128; const float* lk1 = A.in[IN_LK1] + j * 128; const float* lq2 = A.in[IN_LQ2] + j * 128; const float* lk2 = A.in[IN_LK2] + j * 128;
        const float s1 = wave_sum(lq1[lane] * lk1[lane] + lq1[lane + 64] * lk1[lane + 64]), s2 = wave_sum(lq2[lane] * lk2[lane] + lq2[lane + 64] * lk2[lane + 64]);
        float qm = fmaxf(fabsf(A.in[IN_AQG][j * 128 + lane]), fabsf(A.in[IN_AQG][j * 128 + lane + 64])), km = fmaxf(fabsf(A.in[IN_AKG][j * 128 + lane]), fabsf(A.in[IN_AKG][j * 128 + lane + 64]));
#pragma unroll
        for (int o = 1; o < 64; o <<= 1) { qm = fmaxf(qm, __shfl_xor(qm, o)); km = fmaxf(km, __shfl_xor(km, o)); }
        if (lane == 0) { par[0] = expf(s1) - expf(s2) + (0.8f - 0.6f * expf(-0.3f * (float)layer)); par[1] = 128.0f * qm * km * QSCALE * 1.02f; }
    }
    __syncthreads();
    const float lam = par[0], Mb = par[1], lam_init = 0.8f - 0.6f * expf(-0.3f * (float)layer);
    const float* subg = A.in[IN_SUBG] + (size_t)j * 256;
    const int nunits = upd ? 1088 : 1024;
    unsigned off0, off1;
    if (wave < 4) { const int ra = lane >> 4, rb = 4 + (lane >> 4); off0 = (unsigned)(ra * LDP + (((lane & 15) ^ ra) * 8)) * 2u; off1 = (unsigned)(rb * LDP + (((lane & 15) ^ rb) * 8)) * 2u; }
    else { const int rr = (lane & 31) >> 2; off0 = (unsigned)(((rr & 3) + 8 * (rr >> 2)) * LDP + 32 * (lane >> 5) + 8 * (lane & 3)) * 2u; off1 = off0; }
    const int dma_lds = (wave < 4) ? (AT_K + (wave >> 1) * 16384 + (wave & 1) * 8192) : (AT_V + (wave - 4) * 8192);
    LAS float* li_l = (LAS float*)(lds + AT_SCR) + wave * 64;
    for (int it = 0;; ++it) {
        const int L = it * F.G + (int)blockIdx.x;
        if (L >= nunits) break;
        int uid = L;
        if (F.G == 256 && L < 1024) uid = (it * 8 + ((int)blockIdx.x & 7)) * 32 + ((int)blockIdx.x >> 3);
        const bool isctx = uid >= 1024;
        int b, h, qrow0, nt;
        if (!isctx) { const int bh = uid >> 5; b = bh >> 3; h = bh & 7; qrow0 = b * SEQ + (uid & 31) * 128; nt = 68; }
        else { const int v = uid - 1024, bh = v >> 1; b = bh >> 3; h = bh & 7; qrow0 = ML + b * CTXL + (v & 1) * 128; nt = 4; }
#define KEYROW(jt) (isctx ? (ML + b * CTXL + (jt) * 64) : ((jt) < 64 ? (b * SEQ + (jt) * 64) : (ML + b * CTXL + ((jt) - 64) * 64)))
        bf16x8 qr[8];
        { const bf16* qp = PROJ + (size_t)(qrow0 + 32 * g + r32) * LDP + (2 * h + mp) * 128 + hi * 8;
#pragma unroll
          for (int d0 = 0; d0 < 8; ++d0) qr[d0] = *(const GAS bf16x8*)(qp + d0 * 16); }
        f32x16 o[8];
#pragma unroll
        for (int d0 = 0; d0 < 8; ++d0) o[d0] = (f32x16){};
        float l_reg = 0.f;
        const int hoff = (wave < 4) ? (2048 + (2 * h + (wave >> 1)) * 128) : (4096 + h * 256);
#define DMA_TILE(jt, bf) do { const char* tp_ = (const char*)(PROJ + (size_t)KEYROW(jt) * LDP + hoff); \
            _Pragma("unroll") for (int n_ = 0; n_ < 8; ++n_) { const int ub_ = (wave < 4) ? (32 * (wave & 1) + 8 * (n_ >> 1)) * LDP * 2 : ((4 * (n_ >> 2) + 16 * (wave - 4)) * LDP + 64 * (n_ & 3)) * 2; \
                __builtin_amdgcn_global_load_lds((const unsigned*)(tp_ + ub_ + ((n_ & 1) ? off1 : off0)), (LAS unsigned*)(lds + dma_lds + (bf) * 32768 + n_ * 1024), 16, 0, 0); } } while (0)
        DMA_TILE(0, 0);
        VM_WAIT();
        __syncthreads();
        for (int jt = 0; jt < nt; ++jt) {
            const int bf = jt & 1; const bool more = jt + 1 < nt;
            if (more) DMA_TILE(jt + 1, bf ^ 1);
            const LAS unsigned char* Ks = lds + AT_K + bf * 32768 + mp * 16384;
            bf16x8 pa0, pa1, pa2, pa3; float ps = 0.f;
#define PK4(P, BASE, OUT) do { unsigned a0 = cvtpk(P[BASE + 0], P[BASE + 1]), a1 = cvtpk(P[BASE + 2], P[BASE + 3]); \
    unsigned b0 = cvtpk(P[BASE + 4], P[BASE + 5]), b1 = cvtpk(P[BASE + 6], P[BASE + 7]); \
    auto r0 = __builtin_amdgcn_permlane32_swap(a0, b0, false, false); auto r1 = __builtin_amdgcn_permlane32_swap(a1, b1, false, false); \
    v4u w = {r0[0], r1[0], r0[1], r1[1]}; OUT = __builtin_bit_cast(bf16x8, w); } while (0)
            { f32x16 p;
#pragma unroll
              for (int r = 0; r < 16; ++r) p[r] = -Mb;
#pragma unroll
              for (int d0 = 0; d0 < 8; ++d0) { const bf16x8 b0 = *(const LAS bf16x8*)(Ks + KSWZ(r32, (d0 * 16 + hi * 8) * 2)); p = __builtin_amdgcn_mfma_f32_32x32x16_bf16(b0, qr[d0], p, 0, 0, 0); }
#pragma unroll
              for (int r = 0; r < 16; ++r) { p[r] = __builtin_amdgcn_exp2f(p[r]); ps += p[r]; }
              PK4(p, 0, pa0); PK4(p, 8, pa1); }
            __builtin_amdgcn_sched_barrier(0);
            { f32x16 p;
#pragma unroll
              for (int r = 0; r < 16; ++r) p[r] = -Mb;
#pragma unroll
              for (int d0 = 0; d0 < 8; ++d0) { const bf16x8 b1 = *(const LAS bf16x8*)(Ks + KSWZ(32 + r32, (d0 * 16 + hi * 8) * 2)); p = __builtin_amdgcn_mfma_f32_32x32x16_bf16(b1, qr[d0], p, 0, 0, 0); }
#pragma unroll
              for (int r = 0; r < 16; ++r) { p[r] = __builtin_amdgcn_exp2f(p[r]); ps += p[r]; }
              PK4(p, 0, pa2); PK4(p, 8, pa3); }
#undef PK4
            { auto rr = __builtin_amdgcn_permlane32_swap(__float_as_uint(ps), __float_as_uint(ps), false, false); ps = __uint_as_float(rr[0]) + __uint_as_float(rr[1]); }
            l_reg += ps;
            { const LAS unsigned char* vb = lds + AT_V + bf * 32768 + v_rd_base(lane);
              pv_one<0>(o[0], vb, pa0, pa1, pa2, pa3); pv_one<1>(o[1], vb, pa0, pa1, pa2, pa3); pv_one<2>(o[2], vb, pa0, pa1, pa2, pa3); pv_one<3>(o[3], vb, pa0, pa1, pa2, pa3);
              pv_one<4>(o[4], vb, pa0, pa1, pa2, pa3); pv_one<5>(o[5], vb, pa0, pa1, pa2, pa3); pv_one<6>(o[6], vb, pa0, pa1, pa2, pa3); pv_one<7>(o[7], vb, pa0, pa1, pa2, pa3); }
            VM_WAIT();
            __syncthreads();
        }
#undef DMA_TILE
#undef KEYROW
        const int lane_e = lane_id(), r32e = lane_e & 31, hie = lane_e >> 5;
        if (hie == 0) li_l[r32e] = l_reg;
        LDS_WAIT();
        float rli[16];
#pragma unroll
        for (int r = 0; r < 16; ++r) rli[r] = __builtin_amdgcn_rcpf(li_l[crow(r, hie)]);
        LAS float* ex = (LAS float*)lds + (size_t)g * 128 * 64 + lane_e;
        if (mp == 1) {
#pragma unroll
            for (int d0 = 0; d0 < 8; ++d0)
#pragma unroll
                for (int r = 0; r < 16; ++r) ex[(d0 * 16 + r) * 64] = o[d0][r] * rli[r] * lam;
        }
        __syncthreads();
        if (mp == 0) {
            float ssq[16];
#pragma unroll
            for (int r = 0; r < 16; ++r) ssq[r] = 0.f;
#pragma unroll
            for (int d0 = 0; d0 < 8; ++d0)
#pragma unroll
                for (int r = 0; r < 16; ++r) { const float v = o[d0][r] * rli[r] - ex[(d0 * 16 + r) * 64]; o[d0][r] = v; ssq[r] += v * v; }
#pragma unroll
            for (int r = 0; r < 16; ++r) { float s = ssq[r]; s += __shfl_xor(s, 1); s += __shfl_xor(s, 2); s += __shfl_xor(s, 4); s += __shfl_xor(s, 8); s += __shfl_xor(s, 16);
                ssq[r] = (1.0f / sqrtf(s * (1.0f / 256.0f) + EPS)) * (1.0f - lam_init); }
#pragma unroll
            for (int d0 = 0; d0 < 8; ++d0) { const float gs = subg[32 * d0 + r32e];
#pragma unroll
                for (int r = 0; r < 16; ++r) OB[(size_t)(qrow0 + 32 * g + crow(r, hie)) * DM + h * 256 + 32 * d0 + r32e] = (bf16)f2bf(o[d0][r] * ssq[r] * gs); }
        }
        __syncthreads();
    }
}

#ifndef MK_N_LAUNCHES
#define MK_N_LAUNCHES 1
#endif
#ifndef DBG_BAR2
#define DBG_BAR2 0
#endif
#ifndef DBG_REP
#define DBG_REP 0
#endif
#define REPS(kind) (((DBG_REP) & (kind)) ? 2 : 1)
#ifndef HELP_BUDGET
#define HELP_BUDGET 3
#endif
enum { PH_P0 = 1, PH_NORM1 = 2, PH_INPROJ = 4, PH_SCAN = 8, PH_FINISH = 16, PH_QKNORM = 32, PH_ATTN = 64, PH_OUTPROJ = 128, PH_NORM2 = 256, PH_GU = 512, PH_DOWN = 1024, PH_ALL = 2047 };
template <int MASK, bool SEAMS, int LAYER>
__device__ __forceinline__ void run_layer(Frame& F, const Args& A_, const XcdBarrier& bar, int lrt) {
#define LAUNDER_ARGS() const Args& A = A_
#define SEAM() do { if constexpr (SEAMS) { xcd_barrier(bar); if (DBG_BAR2) xcd_barrier(bar); } } while (0)
    {
        const int layer = (LAYER >= 0) ? LAYER : lrt;
        const int j = layer >> 1; const bool last = (layer == LASTL); const bool upd = !last && layer < CTXUPD; const int mrows = upd ? MT : ML;
        if constexpr ((MASK & PH_NORM1) != 0) { if (layer == 0) norm_phase<true>(F, A_, 0, 0, 0, MT, nullptr); else norm_phase<false>(F, A_, layer, 0, ML, MT, (layer - 1 < CTXUPD) ? (const float*)(A_.ws + WS_MOD) + (size_t)((layer - 1) * 5 + 4) * 12288 + 5 * DM : nullptr); SEAM(); }
        if constexpr ((MASK & PH_INPROJ) != 0) { LAUNDER_ARGS();
            const bool ml = (layer & 1) == 0;
            const bf16* W = ml ? (const bf16*)(A.ws + WS_W_MIN) + (size_t)j * MIN_PAD * DM : (const bf16*)(A.ws + WS_W_AIN) + (size_t)j * AIN * DM;
            const int N = ml ? MIN_PAD : AIN;
            pg8::Gemm g{(const bf16*)(A.ws + WS_HN), W, MT, N, DM, DM}; pg8::StaticOrder S; S.init(MT, N, F.G, (int)blockIdx.x);
            pg8::EpiProj E{(bf16*)(A.ws + WS_PROJ), LDP, (float*)(A.ws + WS_GATES), A.in[IN_MGB] + (size_t)j * 32, ml ? 1 : 0,
                           ml ? 0 : 1, A.in[IN_AQG] + (size_t)j * 128, A.in[IN_AKG] + (size_t)j * 128, (PG8_LAS float*)(F.lds + 131072), ML};
            pg8::gemm_phase<pg8::EpiProj, pg8::StaticOrder, PG8_ALIGN, PG8_SP2>(F.lds, g, S, E, F.wave);
            SEAM();
        }
        if ((layer & 1) == 0) {
            if constexpr ((MASK & PH_SCAN) != 0) { mlstm_scan_phase(F, A_); SEAM(); }
            if constexpr ((MASK & PH_FINISH) != 0) { mlstm_finish_phase(F, A_, j); SEAM(); }
        } else {
            if constexpr ((MASK & PH_ATTN) != 0) { attn_phase(F, A_, layer, j, upd); SEAM(); }
        }
        if constexpr ((MASK & PH_OUTPROJ) != 0) { LAUNDER_ARGS(); const float* MODL = (const float*)(A.ws + WS_MOD) + (size_t)layer * 5 * 12288;
            const bool ml = (layer & 1) == 0;
            const bf16* W = ml ? (const bf16*)(A.ws + WS_W_MOUT) + (size_t)j * DM * DM : (const bf16*)(A.ws + WS_W_AOUT) + (size_t)j * DM * DM;
            pg8::Gemm g{(const bf16*)(A.ws + WS_OB), W, ML, DM, DM, DM}; pg8::PanelOrder S; S.init(ML, DM, F.G, (int)blockIdx.x);
            pg8::EpiResidNorm E{(const unsigned short*)(A.ws + WS_X), (unsigned short*)(A.ws + WS_X), MODL + 2 * DM,
                                (bf16*)(A.ws + WS_HN), A.in[IN_NORMG] + (size_t)(layer * 2 + 1) * DM, MODL + 3 * DM,
                                (unsigned long long*)(A.ws + WS_XBUF), 0x51u + 2u * (unsigned)layer, (unsigned*)(A.ws + WS_CTL) + CW_XTMO, (PG8_LAS float*)(F.lds + 131072)};
            pg8::gemm_phase<pg8::EpiResidNorm, pg8::PanelOrder, PG8_ALIGN, PG8_SP2>(F.lds, g, S, E, F.wave);
            if (upd) {
                pg8::Gemm gc{(const bf16*)(A.ws + WS_OB) + (size_t)ML * DM, W, MC, DM, DM / KSPLIT, DM}; pg8::SplitOrder SC; SC.init(MC, DM, KSPLIT, F.G, (int)blockIdx.x);
                pg8::EpiSlab EC{(float*)(A.ws + WS_SLAB), (size_t)MC * DM};
                pg8::gemm_phase<pg8::EpiSlab, pg8::SplitOrder, PG8_ALIGN, PG8_SP2>(F.lds, gc, SC, EC, F.wave);
            }
            SEAM();
        }
        if constexpr ((MASK & PH_NORM2) != 0) { if (upd) { norm_phase<false>(F, A_, layer, 1, ML, MT, (const float*)(A_.ws + WS_MOD) + (size_t)(layer * 5 + 4) * 12288 + 2 * DM); SEAM(); } }
        if constexpr ((MASK & PH_GU) != 0) { LAUNDER_ARGS();
            pg8::Gemm g{(const bf16*)(A.ws + WS_HN), (const bf16*)(A.ws + WS_W_GU) + (size_t)layer * NGU * DM, mrows, NGU, DM, DM}; pg8::StaticOrder S; S.init(mrows, NGU, F.G, (int)blockIdx.x);
            pg8::EpiSwiGLU E{(bf16*)(A.ws + WS_HID), FFH};
            pg8::gemm_phase<pg8::EpiSwiGLU, pg8::StaticOrder, PG8_ALIGN, PG8_SP2>(F.lds, g, S, E, F.wave);
            SEAM();
        }
        if constexpr ((MASK & PH_DOWN) != 0) { LAUNDER_ARGS(); const float* MODL = (const float*)(A.ws + WS_MOD) + (size_t)layer * 5 * 12288;
            const bf16* WD = (const bf16*)(A.ws + WS_W_DN) + (size_t)layer * DM * FFH;
            pg8::Gemm g{(const bf16*)(A.ws + WS_HID), WD, ML, DM, FFH, FFH};
            if (last) { pg8::StaticOrder S; S.init(ML, DM, F.G, (int)blockIdx.x);
                pg8::EpiResid E{(const unsigned short*)(A.ws + WS_X), (void*)A.out, MODL + 5 * DM, 1};
                pg8::gemm_phase<pg8::EpiResid, pg8::StaticOrder, PG8_ALIGN, PG8_SP2>(F.lds, g, S, E, F.wave);
            } else { pg8::PanelOrder S; S.init(ML, DM, F.G, (int)blockIdx.x);
                pg8::EpiResidNorm E{(const unsigned short*)(A.ws + WS_X), (unsigned short*)(A.ws + WS_X), MODL + 5 * DM,
                                    (bf16*)(A.ws + WS_HN), A.in[IN_NORMG] + (size_t)((layer + 1) * 2) * DM, MODL + 5 * 12288,
                                    (unsigned long long*)(A.ws + WS_XBUF), 0x52u + 2u * (unsigned)layer, (unsigned*)(A.ws + WS_CTL) + CW_XTMO, (PG8_LAS float*)(F.lds + 131072)};
                pg8::gemm_phase<pg8::EpiResidNorm, pg8::PanelOrder, PG8_ALIGN, PG8_SP2>(F.lds, g, S, E, F.wave); }
            if (upd) {
                pg8::Gemm gc{(const bf16*)(A.ws + WS_HID) + (size_t)ML * FFH, WD, MC, DM, FFH / KSPLIT, FFH}; pg8::SplitOrder SC; SC.init(MC, DM, KSPLIT, F.G, (int)blockIdx.x);
                pg8::EpiSlab EC{(float*)(A.ws + WS_SLAB), (size_t)MC * DM};
                pg8::gemm_phase<pg8::EpiSlab, pg8::SplitOrder, PG8_ALIGN, PG8_SP2>(F.lds, gc, SC, EC, F.wave);
            }
            if (!last) SEAM();
        }
    }
#undef SEAM
#undef LAUNDER_ARGS
}
template <int MASK, bool SEAMS>
__device__ __forceinline__ void run_program(Frame& F, const Args& A_, const XcdBarrier& bar, int l0, int l1) {
    if constexpr ((MASK & PH_P0) != 0) { p0_prologue(F, A_, DEPTH); if constexpr (SEAMS) xcd_barrier(bar); }
    if constexpr (SEAMS) {
        run_layer<MASK, SEAMS, 0>(F, A_, bar, 0);
        if constexpr (LASTL >= 1) run_layer<MASK, SEAMS, 1>(F, A_, bar, 1);
        if constexpr (LASTL >= 2) run_layer<MASK, SEAMS, 2>(F, A_, bar, 2);
        if constexpr (LASTL >= 3) run_layer<MASK, SEAMS, 3>(F, A_, bar, 3);
    } else {
        if constexpr ((MASK & ~PH_P0) != 0) for (int layer = l0; layer < l1; ++layer) run_layer<MASK, SEAMS, -1>(F, A_, bar, layer);
    }
}
__device__ __forceinline__ void frame_init(Frame& F, unsigned char* lds_raw) {
    F.lds = (LAS unsigned char*)lds_raw;
    F.MISC = (volatile LAS unsigned*)(F.lds + MISC_OFF);
    F.wave = __builtin_amdgcn_readfirstlane((int)threadIdx.x >> 6);
    F.G = gridDim.x; { const int bx = blockIdx.x; F.vcu = (F.G % 8 == 0) ? (bx % 8) * (F.G / 8) + bx / 8 : bx; }
    if (F.wave == 0) F.MISC[lane_id()] = 0u;
    __syncthreads();
}
#if MK_N_LAUNCHES == 1
__global__ void __launch_bounds__(NWAVES * 64, 2) hybrid_fwd(const Args A) {
    extern __shared__ __attribute__((aligned(16))) unsigned char lds_raw[];
    Frame F; frame_init(F, lds_raw);
    const XcdBarrier bar = xcd_barrier_post((unsigned*)(A.ws + WS_CTL) + CW_BAR, F.MISC + 8, F.wave);
    run_program<PH_ALL, true>(F, A, bar, 0, LASTL + 1);
}
#else
template <int MASK> __global__ void __launch_bounds__(NWAVES * 64, 2) hybrid_phase(const Args A) {
    extern __shared__ __attribute__((aligned(16))) unsigned char lds_raw[];
    Frame F; frame_init(F, lds_raw);
    XcdBarrier bar; bar.bar = nullptr; bar.x = 0; bar.st = F.MISC + 8; bar.wave = F.wave;
    run_program<MASK, false>(F, A, bar, A.ph_lo, A.ph_lo + 1);
}
#endif


#ifndef DBG_DUMP
#define DBG_DUMP 0
#endif
#ifndef DBG_HASH
#define DBG_HASH 0
#endif
#ifndef DBG_LASTPH
#define DBG_LASTPH 7
#endif
#if DBG_DUMP
__global__ void __launch_bounds__(256) dbg_dump(const Args A) {
    const size_t n = (size_t)ML * DM;
    for (size_t i = (size_t)blockIdx.x * 256 + threadIdx.x; i < n; i += (size_t)gridDim.x * 256) {
        const size_t row = i / DM, col = i % DM; float v = 0.f;
        if (DBG_DUMP == 1) v = bf_lo(((const bf16*)(A.ws + WS_HN))[i]);
        if (DBG_DUMP == 2) v = bf_lo(((const bf16*)(A.ws + WS_PROJ))[row * LDP + col]);
        if (DBG_DUMP == 8) v = bf_lo(((const bf16*)(A.ws + WS_PROJ))[row * LDP + 2048 + col]);
        if (DBG_DUMP == 9) v = bf_lo(((const bf16*)(A.ws + WS_PROJ))[row * LDP + 4096 + col]);
        if (DBG_DUMP == 3) v = i < (size_t)MT * 32 ? ((const float*)(A.ws + WS_GATES))[i] : 0.f;
        if (DBG_DUMP == 11) v = i < (size_t)MIN_REAL * DM ? bf_lo(((const bf16*)(A.ws + WS_W_MIN))[(size_t)MIN_PAD * DM + i]) : 0.f;
        if (DBG_DUMP == 6) v = bf_lo(((const bf16*)(A.ws + WS_OB))[i]);
        if (DBG_DUMP == 7) v = h_lo((unsigned)((const unsigned short*)(A.ws + WS_X))[i]);
        if (DBG_HASH) v = (float)(__float_as_uint(v) >> 16 & 0xFFu) + (float)(__float_as_uint(v) & 0xFFu);
        A.out[i] = v;
    }
}
#endif

template <class K> static bool prep_kernel(K kern) {
    if (hipFuncSetAttribute((const void*)kern, hipFuncAttributeMaxDynamicSharedMemorySize, LDS_BYTES) != hipSuccess) { fprintf(stderr, "kernel_launch: hipFuncSetAttribute failed\n"); return false; }
    return true;
}
extern "C" void kernel_launch(void* const* d_in, const int* in_sizes, int n_in, void* d_out, int out_size, void* d_ws, size_t ws_size, hipStream_t stream) {
    static int grid = 0;
    if (grid == 0) {
        if (n_in != 22 || out_size != ML * DM || ws_size < WS_END) { fprintf(stderr, "kernel_launch: built for 22 inputs, %d outputs, >= %zu bytes of workspace; got n_in %d, out %d, ws %zu; nothing launched\n", ML * DM, (size_t)WS_END, n_in, out_size, ws_size); grid = -1; return; }
        int dev = 0, cus = 0;
        if (hipGetDevice(&dev) != hipSuccess || hipDeviceGetAttribute(&cus, hipDeviceAttributeMultiprocessorCount, dev) != hipSuccess) { fprintf(stderr, "kernel_launch: device query failed\n"); grid = -1; return; }
        if (cus != 256) { fprintf(stderr, "kernel_launch: built for 256 CUs (the fused-norm epilogue's tile owners must share a round), device has %d; nothing launched\n", cus); grid = -1; return; }
        bool ok = true;
#if MK_N_LAUNCHES == 1
        ok = prep_kernel(hybrid_fwd);
        int per_cu = 0;
        if (hipOccupancyMaxActiveBlocksPerMultiprocessor(&per_cu, (const void*)hybrid_fwd, NWAVES * 64, LDS_BYTES) != hipSuccess || per_cu < 1) fprintf(stderr, "kernel_launch: note: occupancy query reports %d workgroups per CU\n", per_cu);
        (void)hipGetLastError();
#else
        ok = prep_kernel(hybrid_phase<PH_P0>) && prep_kernel(hybrid_phase<PH_NORM1>) && prep_kernel(hybrid_phase<PH_INPROJ>) && prep_kernel(hybrid_phase<PH_SCAN>) && prep_kernel(hybrid_phase<PH_FINISH>) && prep_kernel(hybrid_phase<PH_QKNORM>)
          && prep_kernel(hybrid_phase<PH_ATTN>) && prep_kernel(hybrid_phase<PH_OUTPROJ>) && prep_kernel(hybrid_phase<PH_NORM2>) && prep_kernel(hybrid_phase<PH_GU>) && prep_kernel(hybrid_phase<PH_DOWN>);
#endif
        if (!ok) { grid = -1; return; }
        grid = cus;
    }
    if (grid < 0) return;
    if (hipMemsetAsync((char*)d_ws + WS_CTL, 0, CTL_ZERO_BYTES, stream) != hipSuccess) { fprintf(stderr, "kernel_launch: memset failed\n"); return; }
    Args a{};
    for (int i = 0; i < 22; ++i) a.in[i] = (const float*)d_in[i];
    a.out = (float*)d_out; a.ws = (unsigned char*)d_ws; a.ph_lo = 0; a.ph_hi = 0;
    const dim3 gd(grid), bd(NWAVES * 64);
#if MK_N_LAUNCHES == 1
    hipLaunchKernelGGL(hybrid_fwd, gd, bd, LDS_BYTES, stream, a);
#else
#define LAUNCH(M) do { for (int rp_ = REPS(M) - 1; rp_ >= 0; --rp_) { a.ph_hi = rp_; hipLaunchKernelGGL(hybrid_phase<M>, gd, bd, LDS_BYTES, stream, a); } } while (0)
    LAUNCH(PH_P0);
    for (int layer = 0; layer <= LASTL; ++layer) {
        a.ph_lo = layer;
        const int lastph = (layer == LASTL) ? DBG_LASTPH : 7;
        LAUNCH(PH_NORM1); if (lastph < 1) break; LAUNCH(PH_INPROJ); if (lastph < 2) break;
        if ((layer & 1) == 0) { LAUNCH(PH_SCAN); if (lastph < 3) break; LAUNCH(PH_FINISH); } else { if (lastph < 3) break; LAUNCH(PH_ATTN); }
        if (lastph < 4) break;
        LAUNCH(PH_OUTPROJ); if (lastph < 5) break; LAUNCH(PH_NORM2); if (lastph < 6) break; LAUNCH(PH_GU); if (lastph < 7) break; LAUNCH(PH_DOWN);
    }
#if DBG_DUMP
    hipLaunchKernelGGL(dbg_dump, dim3(2048), dim3(256), 0, stream, a);
#endif
#undef LAUNCH
#endif
    const hipError_t le = hipPeekAtLastError();
    if (le != hipSuccess) fprintf(stderr, "kernel_launch: launch failed: %s\n", hipGetErrorName(le));
}
```
